# Optimizing an MI355X kernel written in HIP

```python
import math
import jax
import jax.numpy as jnp
from jax import lax
import numpy as np

D_MODEL = 1024
BATCH = 2
SEQ = 8192
DEPTH = 1

D_MIX = D_MODEL
ATT_WIDTH = D_MIX // 2
GDN_WIDTH = D_MIX - ATT_WIDTH
ATT_HEAD_DIM = 64
ATT_HEADS = ATT_WIDTH // ATT_HEAD_DIM
Q_LORA_RANK = D_MODEL // 4
IDX_HEADS = 4
IDX_DIM = 64
IDX_ROPE_DIM = 32
TOPK_MAX = 256
Q_BLOCK = 128
GDN_HEAD_DIM = 128
GDN_HEADS = GDN_WIDTH // GDN_HEAD_DIM
GDN_CONV = 4
GDN_CHUNK = 64
D_FF = 2816
ROPE_THETA = 10000.0
NORM_EPS = 1e-6
IN_SPLIT_SIZES = (Q_LORA_RANK, ATT_WIDTH, ATT_WIDTH, IDX_DIM, IDX_HEADS,
                  GDN_WIDTH, GDN_WIDTH, GDN_WIDTH, GDN_WIDTH, GDN_HEADS, GDN_HEADS)
D_IN = sum(IN_SPLIT_SIZES)
IN_SPLIT_POINTS = tuple(sum(IN_SPLIT_SIZES[:i + 1]) for i in range(len(IN_SPLIT_SIZES) - 1))

kernel_name = 'hybrid_dsa_gdn_macaron_layer'

F32 = jnp.float32


def rms_norm(x, g):
    xf = x.astype(F32)
    y = xf * lax.rsqrt(jnp.mean(xf * xf, axis=-1, keepdims=True) + NORM_EPS)
    return (y * g.astype(F32)).astype(x.dtype)


def layer_norm(x, g, b):
    xf = x.astype(F32)
    mu = jnp.mean(xf, axis=-1, keepdims=True)
    xc = xf - mu
    var = jnp.mean(xc * xc, axis=-1, keepdims=True)
    return (xc * lax.rsqrt(var + NORM_EPS) * g.astype(F32) + b.astype(F32)).astype(x.dtype)


def l2_normalize(x):
    xf = x.astype(F32)
    return xf * lax.rsqrt(jnp.sum(xf * xf, axis=-1, keepdims=True) + NORM_EPS)


def rotary(x, pos, rot_dim):
    half = rot_dim // 2
    inv_freq = 1.0 / (ROPE_THETA ** (jnp.arange(half, dtype=F32) / half))
    ang = pos.astype(F32)[:, None] * inv_freq[None, :]
    cos = jnp.cos(ang)[None, :, None, :].astype(x.dtype)
    sin = jnp.sin(ang)[None, :, None, :].astype(x.dtype)
    x1 = x[..., :half]
    x2 = x[..., half:rot_dim]
    return jnp.concatenate([x1 * cos - x2 * sin, x2 * cos + x1 * sin, x[..., rot_dim:]], axis=-1)


def swiglu(x, w_gate, w_up, w_down):
    return (jax.nn.silu(x @ w_gate) * (x @ w_up)) @ w_down


def causal_depthwise_conv(x, w):
    width = w.shape[0]
    L = x.shape[1]
    xp = jnp.pad(x, ((0, 0), (width - 1, 0), (0, 0)))
    out = xp[:, 0:L] * w[0]
    for j in range(1, width):
        out = out + xp[:, j:j + L] * w[j]
    return out


def dsa_sparse_attention(q, k, v, q_idx, k_idx, w_idx):
    B, L, H, Dh = q.shape
    top_k = min(TOPK_MAX, L // 4)
    nb = L // Q_BLOCK
    key_pos = jnp.arange(L, dtype=jnp.int32)
    k_idx_f = k_idx.astype(F32)
    gather = jax.vmap(lambda t, i: t[i])

    def blocks(t):
        return jnp.moveaxis(t.reshape((B, nb, Q_BLOCK) + t.shape[2:]), 1, 0)

    def one_block(args):
        qb, qib, wb, qpos = args
        s = jnp.einsum('bqhd,bsd->bqhs', qib.astype(F32), k_idx_f)
        score = jnp.einsum('bqh,bqhs->bqs', wb.astype(F32), jax.nn.relu(s))
        causal = key_pos[None, :] <= qpos[:, None]
        score = jnp.where(causal[None], score, -jnp.inf)
        _, sel = lax.top_k(score, top_k)
        k_sel = gather(k, sel)
        v_sel = gather(v, sel)
        valid = sel <= qpos[None, :, None]
        logits = jnp.einsum('bqhd,bqkhd->bqhk', qb.astype(F32), k_sel.astype(F32)) * (Dh ** -0.5)
        logits = jnp.where(valid[:, :, None, :], logits, -jnp.inf)
        p = jax.nn.softmax(logits, axis=-1).astype(v.dtype)
        return jnp.einsum('bqhk,bqkhd->bqhd', p, v_sel)

    qpos_blocks = key_pos.reshape(nb, Q_BLOCK)
    out = lax.map(one_block, (blocks(q), blocks(q_idx), blocks(w_idx), qpos_blocks))
    return jnp.moveaxis(out, 0, 1).reshape(B, L, H, Dh)


def gated_delta_rule(q, k, v, g, beta):
    B, L, H, Dk = q.shape
    Dv = v.shape[-1]
    C = GDN_CHUNK
    N = L // C

    def to_chunks(t):
        return t.reshape((B, N, C) + t.shape[2:]).swapaxes(2, 3)

    q = to_chunks(q) * (Dk ** -0.5)
    k = to_chunks(k)
    v = to_chunks(v)
    beta = to_chunks(beta)
    g = jnp.cumsum(to_chunks(g), axis=-1)
    incl = jnp.tril(jnp.ones((C, C), dtype=bool))
    strict = jnp.tril(jnp.ones((C, C), dtype=bool), -1)
    decay = jnp.exp(jnp.where(incl, g[..., :, None] - g[..., None, :], -jnp.inf))
    k_beta = k * beta[..., None]
    v_beta = v * beta[..., None]
    a_mat = jnp.where(strict, jnp.einsum('bnhid,bnhjd->bnhij', k_beta, k) * decay, 0.0)
    rhs = jnp.concatenate([v_beta, k_beta * jnp.exp(g)[..., None]], axis=-1)
    sol = lax.linalg.triangular_solve(a_mat, rhs, left_side=True, lower=True, unit_diagonal=True)
    u = sol[..., :Dv]
    w = sol[..., Dv:]
    qk = jnp.where(incl, jnp.einsum('bnhid,bnhjd->bnhij', q, k) * decay, 0.0)
    g_last = g[..., -1]
    q_dec = q * jnp.exp(g)[..., None]
    k_tail = k * jnp.exp(g_last[..., None] - g)[..., None]

    def step(S, inp):
        q_c, qk_c, u_c, w_c, kt_c, gl_c = inp
        v_new = u_c - jnp.einsum('bhcd,bhde->bhce', w_c, S)
        o = jnp.einsum('bhcd,bhde->bhce', q_c, S) + jnp.einsum('bhij,bhje->bhie', qk_c, v_new)
        S = S * jnp.exp(gl_c)[..., None, None] + jnp.einsum('bhcd,bhce->bhde', kt_c, v_new)
        return S, o

    xs = tuple(jnp.moveaxis(t, 1, 0) for t in (q_dec, qk, u, w, k_tail, g_last))
    S0 = jnp.zeros((B, H, Dk, Dv), F32)
    _, o = lax.scan(step, S0, xs)
    return o.transpose(1, 0, 3, 2, 4).reshape(B, L, H, Dv)


def hybrid_mixer(h, w_in, q_a_norm_g, w_q_b, w_qidx_b, kidx_ln_g, kidx_ln_b,
                 gdn_conv_w, gdn_a_log, gdn_dt_bias, gdn_out_norm_g, w_out):
    B, L, _ = h.shape
    dt = h.dtype
    proj = h @ w_in
    c_q, k_att, v_att, k_idx, w_idx, gq, gk, gv, gz, gb, ga = jnp.split(proj, IN_SPLIT_POINTS, axis=-1)
    pos = jnp.arange(L, dtype=jnp.int32)

    c_q = rms_norm(c_q, q_a_norm_g)
    q = (c_q @ w_q_b).reshape(B, L, ATT_HEADS, ATT_HEAD_DIM)
    q_idx = (c_q @ w_qidx_b).reshape(B, L, IDX_HEADS, IDX_DIM)
    k_att = k_att.reshape(B, L, ATT_HEADS, ATT_HEAD_DIM)
    v_att = v_att.reshape(B, L, ATT_HEADS, ATT_HEAD_DIM)
    k_idx = layer_norm(k_idx, kidx_ln_g, kidx_ln_b)
    q = rotary(q, pos, ATT_HEAD_DIM)
    k_att = rotary(k_att, pos, ATT_HEAD_DIM)
    q_idx = rotary(q_idx, pos, IDX_ROPE_DIM)
    k_idx = rotary(k_idx[:, :, None, :], pos, IDX_ROPE_DIM)[:, :, 0, :]
    att = dsa_sparse_attention(q, k_att, v_att, q_idx, k_idx, w_idx).reshape(B, L, ATT_WIDTH)

    qkv = jax.nn.silu(causal_depthwise_conv(jnp.concatenate([gq, gk, gv], axis=-1), gdn_conv_w))
    gq, gk, gv = jnp.split(qkv, (GDN_WIDTH, 2 * GDN_WIDTH), axis=-1)
    gq = l2_normalize(gq.reshape(B, L, GDN_HEADS, GDN_HEAD_DIM))
    gk = l2_normalize(gk.reshape(B, L, GDN_HEADS, GDN_HEAD_DIM))
    gv = gv.reshape(B, L, GDN_HEADS, GDN_HEAD_DIM).astype(F32)
    beta = jax.nn.sigmoid(gb.astype(F32))
    log_decay = -jnp.exp(gdn_a_log.astype(F32)) * jax.nn.softplus(ga.astype(F32) + gdn_dt_bias.astype(F32))
    o = gated_delta_rule(gq, gk, gv, log_decay, beta)
    z = gz.reshape(B, L, GDN_HEADS, GDN_HEAD_DIM).astype(F32)
    o = rms_norm(o, gdn_out_norm_g) * jax.nn.silu(z)
    gdn = o.reshape(B, L, GDN_WIDTH).astype(dt)

    return jnp.concatenate([att, gdn], axis=-1) @ w_out


def setup_inputs(seed: int = 0) -> dict:
    key = jax.random.key(seed)
    ks = jax.random.split(key, 32)

    def nrm(k, shape, fan_in):
        return jax.random.normal(k, shape, F32) * (fan_in ** -0.5)

    def gain(k, shape):
        return 1.0 + 0.02 * jax.random.normal(k, shape, F32)

    Dp = DEPTH
    x = jax.random.normal(ks[0], (BATCH, SEQ, D_MODEL), F32)
    dt_init = jnp.exp(jax.random.uniform(ks[20], (Dp, GDN_HEADS), F32, math.log(1e-3), math.log(1e-1)))
    return {
        'x': x,
        'ffn1_pre_g': gain(ks[1], (Dp, D_MODEL)),
        'ffn1_post_g': gain(ks[2], (Dp, D_MODEL)),
        'ffn1_w_gate': nrm(ks[3], (Dp, D_MODEL, D_FF), D_MODEL),
        'ffn1_w_up': nrm(ks[4], (Dp, D_MODEL, D_FF), D_MODEL),
        'ffn1_w_down': nrm(ks[5], (Dp, D_FF, D_MODEL), D_FF),
        'mix_pre_g': gain(ks[6], (Dp, D_MODEL)),
        'mix_post_g': gain(ks[7], (Dp, D_MODEL)),
        'w_in': nrm(ks[8], (Dp, D_MODEL, D_IN), D_MODEL),
        'q_a_norm_g': gain(ks[9], (Dp, Q_LORA_RANK)),
        'w_q_b': nrm(ks[10], (Dp, Q_LORA_RANK, ATT_WIDTH), Q_LORA_RANK),
        'w_qidx_b': nrm(ks[11], (Dp, Q_LORA_RANK, IDX_HEADS * IDX_DIM), Q_LORA_RANK),
        'kidx_ln_g': gain(ks[12], (Dp, IDX_DIM)),
        'kidx_ln_b': 0.02 * jax.random.normal(ks[13], (Dp, IDX_DIM), F32),
        'gdn_conv_w': nrm(ks[14], (Dp, GDN_CONV, 3 * GDN_WIDTH), GDN_CONV),
        'gdn_a_log': jnp.log(jax.random.uniform(ks[15], (Dp, GDN_HEADS), F32, 1.0, 16.0)),
        'gdn_dt_bias': dt_init + jnp.log(-jnp.expm1(-dt_init)),
        'gdn_out_norm_g': gain(ks[16], (Dp, GDN_HEAD_DIM)),
        'w_out': nrm(ks[17], (Dp, D_MIX, D_MODEL), D_MIX),
        'ffn2_pre_g': gain(ks[18], (Dp, D_MODEL)),
        'ffn2_post_g': gain(ks[19], (Dp, D_MODEL)),
        'ffn2_w_gate': nrm(ks[21], (Dp, D_MODEL, D_FF), D_MODEL),
        'ffn2_w_up': nrm(ks[22], (Dp, D_MODEL, D_FF), D_MODEL),
        'ffn2_w_down': nrm(ks[23], (Dp, D_FF, D_MODEL), D_FF),
    }


def reference(x, ffn1_pre_g, ffn1_post_g, ffn1_w_gate, ffn1_w_up, ffn1_w_down,
              mix_pre_g, mix_post_g, w_in, q_a_norm_g, w_q_b, w_qidx_b, kidx_ln_g, kidx_ln_b,
              gdn_conv_w, gdn_a_log, gdn_dt_bias, gdn_out_norm_g, w_out,
              ffn2_pre_g, ffn2_post_g, ffn2_w_gate, ffn2_w_up, ffn2_w_down):
    for l in range(DEPTH):
        f = swiglu(rms_norm(x, ffn1_pre_g[l]), ffn1_w_gate[l], ffn1_w_up[l], ffn1_w_down[l])
        x = x + 0.5 * rms_norm(f, ffn1_post_g[l])
        m = hybrid_mixer(rms_norm(x, mix_pre_g[l]), w_in[l], q_a_norm_g[l], w_q_b[l], w_qidx_b[l],
                         kidx_ln_g[l], kidx_ln_b[l], gdn_conv_w[l], gdn_a_log[l], gdn_dt_bias[l],
                         gdn_out_norm_g[l], w_out[l])
        x = x + rms_norm(m, mix_post_g[l])
        f = swiglu(rms_norm(x, ffn2_pre_g[l]), ffn2_w_gate[l], ffn2_w_up[l], ffn2_w_down[l])
        x = x + 0.5 * rms_norm(f, ffn2_post_g[l])
    return x
```

```cpp
#include <hip/hip_runtime.h>
#include <hip/hip_cooperative_groups.h>
#include <hip/hip_bf16.h>
#include <hip/hip_fp16.h>
#include <cstdio>
#include <cstdint>
#include <cmath>
namespace cg = cooperative_groups;
namespace pg8 {
#define PG8_LAS __attribute__((address_space(3)))
typedef unsigned short bf16_t;
typedef short bf16x8 __attribute__((ext_vector_type(8)));
typedef float f32x4 __attribute__((ext_vector_type(4)));
typedef unsigned u32x4 __attribute__((ext_vector_type(4)));
constexpr int BM = 256, BK = 64, HALF = 128, HTB = HALF * BK * 2  , STAGE_BYTES = 8 * HTB, NXCD = 8, WGM = 8;

__host__ __device__ __forceinline__ int lds_byte(int r, int c) { const int st = (r >> 4) * 2 + (c >> 5), rr = r & 15, cc = c & 31, ob = rr * 64 + cc * 2; return st * 1024 + (ob ^ (((ob >> 9) & 1) << 5)); }
__host__ __device__ __forceinline__ void stage_rc(int b, int& R, int& C) { const int st = b / 1024, sb = b % 1024, swz = sb ^ (((sb >> 9) & 1) << 5); R = (st >> 1) * 16 + swz / 64; C = (st & 1) * 32 + (swz % 64) / 2; }
__host__ __device__ __forceinline__ int perm32(int rho) { const int n = rho >> 4, i = rho & 15; return 8 * (i >> 2) + 4 * n + (i & 3); }

struct Unit { int pm, pn; };
struct Gemm { const bf16_t* A; const bf16_t* Bt; int M, N, K; };

struct StaticOrder {
    int nM, nN, nwg, G, c;
    __host__ __device__ void init(int M, int N, int G_, int c_) { nM = M / BM; nN = N / BM; nwg = nM * nN; G = G_; c = c_; }
    __host__ __device__ bool next(int i, Unit& u) const {
        const long L = (long)i * G + c; if (L >= nwg) return false;
        int wgid = (int)L; { const int q = nwg / NXCD, r = nwg % NXCD, xcd = wgid % NXCD, off = wgid / NXCD; wgid = (xcd < r ? xcd * (q + 1) : r * (q + 1) + (xcd - r) * q) + off; }
        const int nig = WGM * nN, gid = wgid / nig, fm = gid * WGM, gsz = (nM - fm) < WGM ? (nM - fm) : WGM;
        u.pm = fm + ((wgid % nig) % gsz); u.pn = (wgid % nig) / gsz; return true;
    }
    __device__ __forceinline__ void a_ready(const Unit&) const {}
    __device__ __forceinline__ void done(const Unit&) const {}
};

__device__ __forceinline__ unsigned cvt_pk_bf16(float lo, float hi) { unsigned r; asm volatile("v_cvt_pk_bf16_f32 %0, %1, %2" : "=v"(r) : "v"(lo), "v"(hi)); return r; }
typedef float f32x2 __attribute__((ext_vector_type(2)));
__device__ __forceinline__ u32x4 pack8(const f32x4 v0, const f32x4 v1) { u32x4 w; w.x = cvt_pk_bf16(v0[0], v0[1]); w.y = cvt_pk_bf16(v0[2], v0[3]); w.z = cvt_pk_bf16(v1[0], v1[1]); w.w = cvt_pk_bf16(v1[2], v1[3]); return w; }
struct EpiPlain {
    static constexpr bool PERM = true, AFTER_DRAIN = false;
    bf16_t* O; int ldc;
    __device__ __forceinline__ void operator()(const f32x4 (&acc)[2][2][4][2], const Unit& u, int wr, int wc, int fr, int fq) const {
        const int row0 = u.pm * BM + wr * 64 + fr, col0 = u.pn * BM + wc * 32 + 8 * fq;
#pragma unroll
        for (int ai = 0; ai < 2; ++ai)
#pragma unroll
            for (int m = 0; m < 4; ++m) { bf16_t* rowp = O + (size_t)(row0 + ai * HALF + m * 16) * ldc + col0;
#pragma unroll
                for (int bj = 0; bj < 2; ++bj) *(u32x4*)(rowp + bj * HALF) = pack8(acc[ai][bj][m][0], acc[ai][bj][m][1]); }
    }
};
__device__ __forceinline__ float silu_f(float g) { return g * __builtin_amdgcn_rcpf(1.0f + __builtin_amdgcn_exp2f(-1.4426950408889634f * g)); }
struct EpiSwiGLU {
    static constexpr bool PERM = true, AFTER_DRAIN = false;
    bf16_t* H; int ldh;
    __device__ __forceinline__ void operator()(const f32x4 (&acc)[2][2][4][2], const Unit& u, int wr, int wc, int fr, int fq) const {
        const int row0 = u.pm * BM + wr * 64 + fr, col0 = u.pn * HALF + wc * 32 + 8 * fq;
#pragma unroll
        for (int ai = 0; ai < 2; ++ai)
#pragma unroll
            for (int m = 0; m < 4; ++m) { bf16_t* rowp = H + (size_t)(row0 + ai * HALF + m * 16) * ldh + col0;
                f32x4 h0, h1;
#pragma unroll
                for (int i = 0; i < 4; ++i) { h0[i] = silu_f(acc[ai][0][m][0][i]) * acc[ai][1][m][0][i]; h1[i] = silu_f(acc[ai][0][m][1][i]) * acc[ai][1][m][1][i]; }
                *(u32x4*)rowp = pack8(h0, h1); }
    }
};
struct EpiInProj {
    static constexpr bool PERM = true, AFTER_DRAIN = false;
    bf16_t *CQ, *KATT, *VATT, *GRAW, *GZ; float* SPEC;
    __device__ __forceinline__ void operator()(const f32x4 (&acc)[2][2][4][2], const Unit& u, int wr, int wc, int fr, int fq) const {
        const int row0 = u.pm * BM + wr * 64 + fr; const int pn = u.pn;
        if (pn == 13) {
            const int col0 = wc * 32 + 8 * fq;
#pragma unroll
            for (int ai = 0; ai < 2; ++ai)
#pragma unroll
                for (int m = 0; m < 4; ++m) { float* rowp = SPEC + (size_t)(row0 + ai * HALF + m * 16) * 128 + col0;
                    *(f32x4*)rowp = acc[ai][0][m][0]; *(f32x4*)(rowp + 4) = acc[ai][0][m][1]; }
            return;
        }
        bf16_t* base; int ldc, ct;
        if (pn == 0) { base = CQ; ldc = 256; ct = 0; }
        else if (pn < 3) { base = KATT; ldc = 512; ct = (pn - 1) * 256; }
        else if (pn < 5) { base = VATT; ldc = 512; ct = (pn - 3) * 256; }
        else if (pn < 11) { base = GRAW; ldc = 1536; ct = (pn - 5) * 256; }
        else { base = GZ; ldc = 512; ct = (pn - 11) * 256; }
        const int col0 = ct + wc * 32 + 8 * fq;
#pragma unroll
        for (int ai = 0; ai < 2; ++ai)
#pragma unroll
            for (int m = 0; m < 4; ++m) { bf16_t* rowp = base + (size_t)(row0 + ai * HALF + m * 16) * ldc + col0;
#pragma unroll
                for (int bj = 0; bj < 2; ++bj) *(u32x4*)(rowp + bj * HALF) = pack8(acc[ai][bj][m][0], acc[ai][bj][m][1]); }
    }
};
template <class Epi, class Sched, bool ALIGN_EPI = false, bool SP2 = false>
__device__ __forceinline__ void gemm_phase(PG8_LAS unsigned char* lds, const Gemm g, const Sched& S, const Epi& E) {
    const int tid = threadIdx.x, wid = __builtin_amdgcn_readfirstlane(tid >> 6), lane = tid & 63, wr = wid >> 2, wc = wid & 3, fr = lane & 15, fq = lane >> 4;
    const int K = g.K, nt = K / BK;
    unsigned voffA[2], voffB[2];
#pragma unroll
    for (int i = 0; i < 2; ++i) { int R, C; stage_rc(tid * 16 + i * 8192, R, C); const int Rb = Epi::PERM ? ((R & ~31) + perm32(R & 31)) : R;
        voffA[i] = (unsigned)(R * K + C) * 2u; voffB[i] = (unsigned)(Rb * K + C) * 2u; }
    const size_t kstep = (size_t)(BK * 2);
    const size_t hstep = (size_t)HALF * K * 2;
    const size_t tstep = 2 * hstep;
    const unsigned ldsw = (unsigned)wid * 1024u;
    const int aoff = lds_byte(wr * 64 + fr, fq * 8), boff = lds_byte(wc * 32 + fr, fq * 8);
#define PG8_SA(b, h) (((b) * 2 + (h)) * HTB)
#define PG8_SB(b, h) ((4 + (b) * 2 + (h)) * HTB)
#define PG8_STAGE(bufoff, gbase, voff) do { _Pragma("unroll") for (int _i = 0; _i < 2; ++_i) \
        __builtin_amdgcn_global_load_lds((const unsigned*)((const char*)(gbase) + (voff)[_i]), (PG8_LAS unsigned*)(lds + (bufoff) + ldsw + _i * 8192), 16, 0, 0); } while (0)
#define PG8_LDA(dst, b, h) do { _Pragma("unroll") for (int m = 0; m < 4; ++m) _Pragma("unroll") for (int k = 0; k < 2; ++k) dst[m][k] = *(const PG8_LAS bf16x8*)(lds + PG8_SA(b, h) + aoff + m * 2048 + k * 1024); } while (0)
#define PG8_LDB(dst, b, h) do { _Pragma("unroll") for (int n = 0; n < 2; ++n) _Pragma("unroll") for (int k = 0; k < 2; ++k) dst[n][k] = *(const PG8_LAS bf16x8*)(lds + PG8_SB(b, h) + boff + n * 2048 + k * 1024); } while (0)
#define PG8_MMA(ai, bj, At, Bt) do { __builtin_amdgcn_s_setprio(1); _Pragma("unroll") for (int m = 0; m < 4; ++m) _Pragma("unroll") for (int n = 0; n < 2; ++n) _Pragma("unroll") for (int k = 0; k < 2; ++k) \
        acc[ai][bj][m][n] = __builtin_amdgcn_mfma_f32_16x16x32_bf16(Bt[n][k], At[m][k], acc[ai][bj][m][n], 0, 0, 0); __builtin_amdgcn_s_setprio(0); } while (0)
#define PG8_WAIT_V(n) asm volatile("s_waitcnt vmcnt(" #n ")" ::: "memory")
#define PG8_WAIT_L(n) asm volatile("s_waitcnt lgkmcnt(" #n ")" ::: "memory")
#define PG8_BAR __builtin_amdgcn_s_barrier()
#define PG8_SCHED __builtin_amdgcn_sched_barrier(0)
    Unit cur, nxt; int ui = 0;
    if (!S.next(0, cur)) return;
    f32x4 acc[2][2][4][2];
#pragma unroll
    for (int a = 0; a < 2; ++a)
#pragma unroll
        for (int b = 0; b < 2; ++b)
#pragma unroll
            for (int m = 0; m < 4; ++m)
#pragma unroll
                for (int n = 0; n < 2; ++n) acc[a][b][m][n] = (f32x4){0.f, 0.f, 0.f, 0.f};
    bf16x8 At[4][2], B0[2][2], B1[2][2];
    const char* cA = (const char*)g.A + (size_t)cur.pm * tstep; const char* cB = (const char*)g.Bt + (size_t)cur.pn * tstep;
    S.a_ready(cur);
    if constexpr (SP2) {
        PG8_STAGE(PG8_SB(0, 0), cB, voffB); PG8_STAGE(PG8_SB(0, 1), cB + hstep, voffB); PG8_STAGE(PG8_SA(0, 0), cA, voffA); PG8_STAGE(PG8_SA(0, 1), cA + hstep, voffA);
        if (wr == 1) PG8_BAR;
        PG8_WAIT_V(2); PG8_BAR;
        PG8_STAGE(PG8_SB(1, 0), cB + kstep, voffB); PG8_STAGE(PG8_SA(1, 0), cA + kstep, voffA); PG8_STAGE(PG8_SB(1, 1), cB + hstep + kstep, voffB);
        PG8_WAIT_V(6); PG8_BAR;
    } else {
        PG8_STAGE(PG8_SB(0, 0), cB, voffB); PG8_STAGE(PG8_SA(0, 0), cA, voffA); PG8_STAGE(PG8_SB(0, 1), cB + hstep, voffB); PG8_STAGE(PG8_SA(0, 1), cA + hstep, voffA);
        if (wr == 1) PG8_BAR;
        PG8_WAIT_V(4); PG8_BAR;
        PG8_STAGE(PG8_SB(1, 0), cB + kstep, voffB); PG8_STAGE(PG8_SA(1, 0), cA + kstep, voffA); PG8_STAGE(PG8_SB(1, 1), cB + hstep + kstep, voffB);
        PG8_WAIT_V(6); PG8_BAR;
    }
    for (;;) {
        const bool has_next = S.next(ui + 1, nxt);
        const char* nA = has_next ? (const char*)g.A + (size_t)nxt.pm * tstep : cA; const char* nB = has_next ? (const char*)g.Bt + (size_t)nxt.pn * tstep : cB;
        for (int t = 0; t < nt; t += 2) {
            const bool last = (t == nt - 2);
            const char* a1 = cA + (size_t)(t + 1) * kstep;
            const char* a2 = last ? nA : cA + (size_t)(t + 2) * kstep; const char* b2 = last ? nB : cB + (size_t)(t + 2) * kstep;
            const char* a3 = a2 + kstep; const char* b3 = b2 + kstep;
            if (last && has_next) S.a_ready(nxt);
            if constexpr (SP2) {
            PG8_LDB(B0, 0, 0); PG8_LDB(B1, 0, 1); PG8_SCHED; PG8_LDA(At, 0, 0); PG8_STAGE(PG8_SA(1, 1), a1 + hstep, voffA);
            PG8_WAIT_V(8); PG8_WAIT_L(0); PG8_BAR; PG8_MMA(0, 0, At, B0); PG8_MMA(0, 1, At, B1); PG8_BAR; PG8_SCHED;
            PG8_LDA(At, 0, 1); PG8_STAGE(PG8_SB(0, 0), b2, voffB); PG8_STAGE(PG8_SB(0, 1), b2 + hstep, voffB); PG8_STAGE(PG8_SA(0, 0), a2, voffA);
            PG8_WAIT_V(8); PG8_WAIT_L(0); PG8_BAR; PG8_MMA(1, 0, At, B0); PG8_MMA(1, 1, At, B1); PG8_BAR; PG8_SCHED;
            PG8_LDB(B0, 1, 0); PG8_LDB(B1, 1, 1); PG8_SCHED; PG8_LDA(At, 1, 0); PG8_STAGE(PG8_SA(0, 1), a2 + hstep, voffA);
            PG8_WAIT_V(8); PG8_WAIT_L(0); PG8_BAR; PG8_MMA(0, 0, At, B0); PG8_MMA(0, 1, At, B1); PG8_BAR; PG8_SCHED;
            PG8_LDA(At, 1, 1); PG8_STAGE(PG8_SB(1, 0), b3, voffB); PG8_STAGE(PG8_SB(1, 1), b3 + hstep, voffB); PG8_STAGE(PG8_SA(1, 0), a3, voffA);
            PG8_WAIT_V(8); PG8_WAIT_L(0); PG8_BAR; PG8_MMA(1, 0, At, B0); PG8_MMA(1, 1, At, B1); PG8_BAR; PG8_SCHED;
            } else {
            PG8_LDB(B0, 0, 0); PG8_SCHED; PG8_LDA(At, 0, 0); PG8_STAGE(PG8_SA(1, 1), a1 + hstep, voffA);
            PG8_WAIT_L(8); PG8_BAR; PG8_WAIT_L(0); PG8_MMA(0, 0, At, B0); PG8_BAR; PG8_SCHED;
            PG8_LDB(B1, 0, 1); PG8_STAGE(PG8_SB(0, 0), b2, voffB);
            PG8_BAR; PG8_WAIT_L(0); PG8_MMA(0, 1, At, B1); PG8_BAR;
            PG8_LDA(At, 0, 1); PG8_STAGE(PG8_SA(0, 0), a2, voffA);
            PG8_BAR; PG8_WAIT_L(0); PG8_MMA(1, 0, At, B0); PG8_BAR; PG8_SCHED;
            PG8_STAGE(PG8_SB(0, 1), b2 + hstep, voffB);
            PG8_WAIT_V(6); PG8_BAR; PG8_MMA(1, 1, At, B1); PG8_BAR;
            PG8_LDB(B0, 1, 0); PG8_SCHED; PG8_LDA(At, 1, 0); PG8_STAGE(PG8_SA(0, 1), a2 + hstep, voffA);
            PG8_WAIT_L(8); PG8_BAR; PG8_WAIT_L(0); PG8_MMA(0, 0, At, B0); PG8_BAR; PG8_SCHED;
            PG8_LDB(B1, 1, 1); PG8_STAGE(PG8_SB(1, 0), b3, voffB);
            PG8_BAR; PG8_WAIT_L(0); PG8_MMA(0, 1, At, B1); PG8_BAR;
            PG8_LDA(At, 1, 1); PG8_STAGE(PG8_SA(1, 0), a3, voffA);
            PG8_BAR; PG8_WAIT_L(0); PG8_MMA(1, 0, At, B0); PG8_BAR; PG8_SCHED;
            PG8_STAGE(PG8_SB(1, 1), b3 + hstep, voffB);
            PG8_WAIT_V(6); PG8_BAR; PG8_MMA(1, 1, At, B1); PG8_BAR;
            }
        }
        if constexpr (ALIGN_EPI) { if (wr == 0) PG8_BAR; }
        if constexpr (!Epi::AFTER_DRAIN) { E(acc, cur, wr, wc, fr, fq); S.done(cur); }
        if (!has_next) break;
#pragma unroll
        for (int a = 0; a < 2; ++a)
#pragma unroll
            for (int b = 0; b < 2; ++b)
#pragma unroll
                for (int m = 0; m < 4; ++m)
#pragma unroll
                    for (int n = 0; n < 2; ++n) acc[a][b][m][n] = (f32x4){0.f, 0.f, 0.f, 0.f};
        cur = nxt; cA = nA; cB = nB; ++ui;
        if constexpr (ALIGN_EPI) { if (wr == 1) PG8_BAR; }
    }
    PG8_WAIT_V(0);
    if constexpr (!ALIGN_EPI) { if (wr == 0) PG8_BAR; }
    PG8_BAR;
    if constexpr (Epi::AFTER_DRAIN) { E.fused(acc, cur, wr, wc, fr, fq, lds, wid, lane); S.done(cur); }
#undef PG8_SA
#undef PG8_SB
#undef PG8_STAGE
#undef PG8_LDA
#undef PG8_LDB
#undef PG8_MMA
#undef PG8_WAIT_V
#undef PG8_WAIT_L
#undef PG8_BAR
#undef PG8_SCHED
}
}
constexpr int NWAVES = 8, NTHR = 512;
constexpr int BATCH = 2, SEQ = 8192, TT = BATCH * SEQ, DM = 1024, DFF = 2816, DIN = 3404, DINP = 3584;
constexpr int TOPK = 256;
constexpr float NORM_EPS = 1e-6f;
constexpr float C2 = 0.125f * 1.4426950408889634f;
constexpr size_t MiB = 1u << 20;
constexpr size_t WS_CTL = 0, CTL_ZERO_BYTES = 1 * MiB;
constexpr size_t WS_W1A = 1 * MiB, WS_W1B = 12 * MiB, WS_W2A = 35 * MiB / 2, WS_W2B = 57 * MiB / 2, WS_WIN = 34 * MiB, WS_WQ = 41 * MiB, WS_WOUT = 83 * MiB / 2;
constexpr size_t WS_XN = 44 * MiB, WS_FB = 76 * MiB, WS_HID = 108 * MiB;
constexpr size_t WS_CQ = 76 * MiB, WS_KATT = 84 * MiB, WS_VATT = 100 * MiB, WS_GRAW = 116 * MiB, WS_GZ = 164 * MiB, WS_SPEC = 180 * MiB;
constexpr size_t WS_KIDX = 188 * MiB, WS_BETA = 190 * MiB, WS_GLOG = 190 * MiB + MiB / 4, WS_GQ = 192 * MiB, WS_GK = 208 * MiB, WS_GV = 224 * MiB;
constexpr size_t WS_QRAW = 116 * MiB, WS_Q = 44 * MiB, WS_QIDX = 60 * MiB;
constexpr size_t WS_MASK = 116 * MiB, WS_CAT = 132 * MiB;
constexpr size_t WS_END = 256 * MiB;
constexpr int RING_BYTES = 131072, LDS_BYTES = 147456;

#define GAS __attribute__((address_space(1)))
#define LAS __attribute__((address_space(3)))
typedef unsigned short bf16;
typedef unsigned v4u __attribute__((ext_vector_type(4)));
typedef unsigned v2u __attribute__((ext_vector_type(2)));
typedef float f32x4 __attribute__((ext_vector_type(4)));
#define LDS_WAIT() asm volatile("s_waitcnt lgkmcnt(0)" ::: "memory")

__device__ __forceinline__ unsigned f2bf(float f) { unsigned u = __builtin_bit_cast(unsigned, f); return (u + 0x7fffu + ((u >> 16) & 1u)) >> 16; }
__device__ __forceinline__ unsigned pk2(float lo, float hi) { return f2bf(lo) | (f2bf(hi) << 16); }
__device__ __forceinline__ float bf2f(unsigned short h) { return __builtin_bit_cast(float, (unsigned)h << 16); }
__device__ __forceinline__ float bflo(unsigned w) { return __builtin_bit_cast(float, w << 16); }
__device__ __forceinline__ float bfhi(unsigned w) { return __builtin_bit_cast(float, w & 0xffff0000u); }
__device__ __forceinline__ float wave_sum(float v) {
#pragma unroll
    for (int o = 1; o < 64; o <<= 1) v += __shfl_xor(v, o);
    return v;
}
__device__ __forceinline__ float wave_max(float v) {
#pragma unroll
    for (int o = 1; o < 64; o <<= 1) v = fmaxf(v, __shfl_xor(v, o));
    return v;
}
__device__ __forceinline__ float sigmoid_f(float x) { return __builtin_amdgcn_rcpf(1.0f + __builtin_amdgcn_exp2f(-1.4426950408889634f * x)); }
__device__ __forceinline__ float silu2(float x) { return x * sigmoid_f(x); }
__device__ __forceinline__ void rope_cs(float pos, float invf, float& c, float& s) {
    const float ang = pos * invf; double rev = (double)ang * 0.15915494309189535; rev -= __builtin_floor(rev); const float r = (float)rev;
    s = __builtin_amdgcn_sinf(r); c = __builtin_amdgcn_cosf(r);
}

struct Args { const float* in[24]; float* out; unsigned char* ws; float invf_att[32]; float invf_idx[16]; int ph_lo, ph_hi; };
enum { I_X = 0, I_F1PRE, I_F1POST, I_F1G, I_F1U, I_F1D, I_MPRE, I_MPOST, I_WIN, I_QAG, I_WQB, I_WQIB, I_KLG, I_KLB, I_CONV, I_ALOG, I_DTB, I_GOUTG, I_WOUT, I_F2PRE, I_F2POST, I_F2G, I_F2U, I_F2D };

struct Frame {
    LAS unsigned char* lds;
    int tid, lane, wave, G, bid;
    unsigned char* ws;
};

__device__ __forceinline__ void transpose_item(const float* W, int Nsrc, int K, bf16* WT, int n0, int sc, int k0, LAS float* scr, int lane) {
#pragma unroll 8
    for (int i = 0; i < 32; ++i) { const int kk = 2 * i + (lane >> 5); scr[kk * 33 + (lane & 31)] = sc >= 0 ? W[(size_t)(k0 + kk) * Nsrc + sc] : 0.f; }
    LDS_WAIT(); asm volatile("" ::: "memory");
    const int c = lane & 7;
#pragma unroll
    for (int j = 0; j < 4; ++j) { const int n = (lane >> 3) + 8 * j; const LAS float* s = scr + (8 * c) * 33 + n;
        v4u o; o.x = pk2(s[0 * 33], s[1 * 33]); o.y = pk2(s[2 * 33], s[3 * 33]); o.z = pk2(s[4 * 33], s[5 * 33]); o.w = pk2(s[6 * 33], s[7 * 33]);
        *(GAS v4u*)(WT + (size_t)(n0 + n) * K + k0 + 8 * c) = o; }
    LDS_WAIT(); asm volatile("" ::: "memory");
}
__device__ __forceinline__ int inproj_src(int r) {
    if (r < 1280) return r;
    if (r < 3328) return r + 68;
    if (r < 3392) return 1280 + (r - 3328);
    if (r < 3396) return 1344 + (r - 3392);
    if (r < 3404) return r;
    return -1;
}
__device__ __forceinline__ void rms_row_to_bf16(const float* xrow, const float* g, bf16* orow, int lane) {
    const GAS f32x4* xr = (const GAS f32x4*)xrow + lane; const GAS f32x4* gr = (const GAS f32x4*)g + lane;
    f32x4 v[4]; float s = 0.f;
#pragma unroll
    for (int j = 0; j < 4; ++j) { v[j] = xr[64 * j]; s += (v[j].x * v[j].x + v[j].y * v[j].y) + (v[j].z * v[j].z + v[j].w * v[j].w); }
    const float rstd = 1.0f / sqrtf(wave_sum(s) * (1.f / DM) + NORM_EPS);
    GAS v2u* o8 = (GAS v2u*)orow + lane;
#pragma unroll
    for (int j = 0; j < 4; ++j) { const f32x4 gg = gr[64 * j]; v2u o; o.x = pk2(v[j].x * rstd * gg.x, v[j].y * rstd * gg.y); o.y = pk2(v[j].z * rstd * gg.z, v[j].w * rstd * gg.w); o8[64 * j] = o; }
}
__device__ __forceinline__ void p_prologue(Frame& F, const Args& A) {
    LAS float* scr = (LAS float*)(F.lds + F.wave * 16384);
    const int gw = F.bid * NWAVES + F.wave, NGW = F.G * NWAVES, lane = F.lane;
    bf16* W1A = (bf16*)(F.ws + WS_W1A); bf16* W1B = (bf16*)(F.ws + WS_W1B); bf16* W2A = (bf16*)(F.ws + WS_W2A); bf16* W2B = (bf16*)(F.ws + WS_W2B);
    bf16* WIN = (bf16*)(F.ws + WS_WIN); bf16* WQ = (bf16*)(F.ws + WS_WQ); bf16* WOUT = (bf16*)(F.ws + WS_WOUT);
    constexpr int I_A = (DM / 64) * (2 * DFF / 32), I_B = (DFF / 64) * (DM / 32), I_IN = (DM / 64) * (DINP / 32), I_Q = (256 / 64) * (768 / 32), I_O = (DM / 64) * (DM / 32);
    constexpr int NITEMS = 2 * I_A + 2 * I_B + I_IN + I_Q + I_O;
    for (int it = gw; it < NITEMS; it += NGW) {
        int r = it;
        if (r < 2 * I_A) { const int f = r / I_A; r -= f * I_A; const int nblk = 2 * DFF / 32, kb = r / nblk, nb = r % nblk, n0 = nb * 32;
            const int tile = n0 >> 8, within = n0 & 255; const bool up = within >= 128; const int sc = tile * 128 + (within & 127) + (lane & 31);
            const float* W = A.in[f ? (up ? I_F2U : I_F2G) : (up ? I_F1U : I_F1G)];
            transpose_item(W, DFF, DM, f ? W2A : W1A, n0, sc, kb * 64, scr, lane); continue; }
        r -= 2 * I_A;
        if (r < 2 * I_B) { const int f = r / I_B; r -= f * I_B; const int nblk = DM / 32, kb = r / nblk, nb = r % nblk, n0 = nb * 32;
            transpose_item(A.in[f ? I_F2D : I_F1D], DM, DFF, f ? W2B : W1B, n0, n0 + (lane & 31), kb * 64, scr, lane); continue; }
        r -= 2 * I_B;
        if (r < I_IN) { const int nblk = DINP / 32, kb = r / nblk, nb = r % nblk, n0 = nb * 32;
            transpose_item(A.in[I_WIN], DIN, DM, WIN, n0, inproj_src(n0 + (lane & 31)), kb * 64, scr, lane); continue; }
        r -= I_IN;
        if (r < I_Q) { const int nblk = 768 / 32, kb = r / nblk, nb = r % nblk, n0 = nb * 32;
            if (n0 < 512) transpose_item(A.in[I_WQB], 512, 256, WQ, n0, n0 + (lane & 31), kb * 64, scr, lane);
            else transpose_item(A.in[I_WQIB], 256, 256, WQ, n0, n0 - 512 + (lane & 31), kb * 64, scr, lane);
            continue; }
        r -= I_Q;
        { const int nblk = DM / 32, kb = r / nblk, nb = r % nblk, n0 = nb * 32;
            transpose_item(A.in[I_WOUT], DM, DM, WOUT, n0, n0 + (lane & 31), kb * 64, scr, lane); }
    }
    bf16* XN = (bf16*)(F.ws + WS_XN);
    for (int m = gw; m < TT; m += NGW) rms_row_to_bf16(A.in[I_X] + (size_t)m * DM, A.in[I_F1PRE], XN + (size_t)m * DM, lane);
}

__device__ __forceinline__ void p_rowpass(Frame& F, const bf16* FB, const float* xin, const float* gpost, float scale, float* xout, const float* gnext, bf16* XN) {
    const int gw = F.bid * NWAVES + F.wave, NGW = F.G * NWAVES, lane = F.lane;
    for (int m = gw; m < TT; m += NGW) {
        const GAS v4u* fr = (const GAS v4u*)(FB + (size_t)m * DM) + lane;
        float f[16]; float s = 0.f;
#pragma unroll
        for (int j = 0; j < 2; ++j) { const v4u w = fr[64 * j];
            f[8 * j + 0] = bflo(w.x); f[8 * j + 1] = bfhi(w.x); f[8 * j + 2] = bflo(w.y); f[8 * j + 3] = bfhi(w.y); f[8 * j + 4] = bflo(w.z); f[8 * j + 5] = bfhi(w.z); f[8 * j + 6] = bflo(w.w); f[8 * j + 7] = bfhi(w.w); }
#pragma unroll
        for (int i = 0; i < 16; ++i) s += f[i] * f[i];
        const float rstd = 1.0f / sqrtf(wave_sum(s) * (1.f / DM) + NORM_EPS) * scale;
        float xn[16]; float s2 = 0.f;
#pragma unroll
        for (int j = 0; j < 2; ++j)
#pragma unroll
            for (int q = 0; q < 2; ++q) { const int c = 512 * j + 8 * lane + 4 * q; const f32x4 xi = *(const GAS f32x4*)(xin + (size_t)m * DM + c); const f32x4 gp = *(const GAS f32x4*)(gpost + c);
                f32x4 o;
#pragma unroll
                for (int i = 0; i < 4; ++i) { o[i] = xi[i] + f[8 * j + 4 * q + i] * rstd * gp[i]; xn[8 * j + 4 * q + i] = o[i]; s2 += o[i] * o[i]; }
                *(GAS f32x4*)(xout + (size_t)m * DM + c) = o; }
        if (gnext) {
            const float r2 = 1.0f / sqrtf(wave_sum(s2) * (1.f / DM) + NORM_EPS);
#pragma unroll
            for (int j = 0; j < 2; ++j) { const int c = 512 * j + 8 * lane; const f32x4 g0 = *(const GAS f32x4*)(gnext + c), g1 = *(const GAS f32x4*)(gnext + c + 4);
                v4u o; o.x = pk2(xn[8 * j + 0] * r2 * g0[0], xn[8 * j + 1] * r2 * g0[1]); o.y = pk2(xn[8 * j + 2] * r2 * g0[2], xn[8 * j + 3] * r2 * g0[3]);
                o.z = pk2(xn[8 * j + 4] * r2 * g1[0], xn[8 * j + 5] * r2 * g1[1]); o.w = pk2(xn[8 * j + 6] * r2 * g1[2], xn[8 * j + 7] * r2 * g1[3]);
                *(GAS v4u*)(XN + (size_t)m * DM + c) = o; }
        }
    }
}

__device__ __forceinline__ void p_prep1(Frame& F, const Args& A) {
    const int gw = F.bid * NWAVES + F.wave, NGW = F.G * NWAVES, lane = F.lane;
    bf16* CQ = (bf16*)(F.ws + WS_CQ); bf16* KATT = (bf16*)(F.ws + WS_KATT); const bf16* GRAW = (const bf16*)(F.ws + WS_GRAW); const float* SPEC = (const float*)(F.ws + WS_SPEC);
    __half* KIDX = (__half*)(F.ws + WS_KIDX); float* BETA = (float*)(F.ws + WS_BETA); float* GLOG = (float*)(F.ws + WS_GLOG);
    bf16* GQ = (bf16*)(F.ws + WS_GQ); bf16* GK = (bf16*)(F.ws + WS_GK); bf16* GV = (bf16*)(F.ws + WS_GV);
    const float* convw = A.in[I_CONV];
    for (int m = gw; m < TT; m += NGW) {
        const int t = m & (SEQ - 1); const float pos = (float)t;
        { GAS v2u* p = (GAS v2u*)(CQ + (size_t)m * 256) + lane; const v2u w = *p; const float a0 = bflo(w.x), a1 = bfhi(w.x), a2 = bflo(w.y), a3 = bfhi(w.y);
          const float rstd = 1.0f / sqrtf(wave_sum(a0 * a0 + a1 * a1 + a2 * a2 + a3 * a3) * (1.f / 256) + NORM_EPS); const f32x4 g = *(const GAS f32x4*)(A.in[I_QAG] + 4 * lane);
          v2u o; o.x = pk2(a0 * rstd * g[0], a1 * rstd * g[1]); o.y = pk2(a2 * rstd * g[2], a3 * rstd * g[3]); *p = o; }
        { const int hd = lane >> 3, d0 = (lane & 7) * 4; GAS v2u* p1 = (GAS v2u*)(KATT + (size_t)m * 512 + hd * 64 + d0); GAS v2u* p2 = (GAS v2u*)(KATT + (size_t)m * 512 + hd * 64 + d0 + 32);
          const v2u w1 = *p1, w2 = *p2; float x1[4] = {bflo(w1.x), bfhi(w1.x), bflo(w1.y), bfhi(w1.y)}, x2[4] = {bflo(w2.x), bfhi(w2.x), bflo(w2.y), bfhi(w2.y)}; float o1[4], o2[4];
#pragma unroll
          for (int i = 0; i < 4; ++i) { float c, s; rope_cs(pos, A.invf_att[d0 + i], c, s); o1[i] = x1[i] * c - x2[i] * s; o2[i] = x2[i] * c + x1[i] * s; }
          v2u a, b; a.x = pk2(o1[0], o1[1]); a.y = pk2(o1[2], o1[3]); b.x = pk2(o2[0], o2[1]); b.y = pk2(o2[2], o2[3]); *p1 = a; *p2 = b; }
        { const float v = SPEC[(size_t)m * 128 + lane]; const float mu = wave_sum(v) * (1.f / 64); const float xc = v - mu; const float var = wave_sum(xc * xc) * (1.f / 64);
          const float y = xc * (1.0f / sqrtf(var + NORM_EPS)) * A.in[I_KLG][lane] + A.in[I_KLB][lane];
          const float part = __shfl_xor(y, 16); float c, s; rope_cs(pos, A.invf_idx[lane & 15], c, s);
          float o = y; if (lane < 16) o = y * c - part * s; else if (lane < 32) o = y * c + part * s;
          KIDX[(size_t)m * 64 + lane] = __float2half(o); }
        if (lane < 4) { const float gb = SPEC[(size_t)m * 128 + 68 + lane], ga = SPEC[(size_t)m * 128 + 72 + lane];
          BETA[(size_t)m * 4 + lane] = sigmoid_f(gb);
          const float xx = ga + A.in[I_DTB][lane]; const float sp = fmaxf(xx, 0.f) + log1pf(__expf(-fabsf(xx)));
          GLOG[(size_t)m * 4 + lane] = -__expf(A.in[I_ALOG][lane]) * sp; }
#pragma unroll 2
        for (int j = 0; j < 12; ++j) { const int c = 128 * j + 2 * lane; float y0 = 0.f, y1 = 0.f;
#pragma unroll
            for (int jj = 0; jj < 4; ++jj) { const int tt = t - 3 + jj; if (tt >= 0) { const unsigned w = *(const GAS unsigned*)(GRAW + (size_t)(m - 3 + jj) * 1536 + c);
                const float w0 = convw[jj * 1536 + c], w1 = convw[jj * 1536 + c + 1]; y0 += w0 * bflo(w); y1 += w1 * bfhi(w); } }
            y0 = silu2(y0); y1 = silu2(y1);
            if (j < 8) { const float r = 1.0f / sqrtf(wave_sum(y0 * y0 + y1 * y1) + NORM_EPS); y0 *= r; y1 *= r; }
            bf16* dst = j < 4 ? GQ : (j < 8 ? GK : GV);
            *(GAS unsigned*)(dst + (size_t)m * 512 + (c & 511)) = pk2(y0, y1); }
    }
}
__device__ __forceinline__ void p_prep2(Frame& F, const Args& A) {
    const int gw = F.bid * NWAVES + F.wave, NGW = F.G * NWAVES, lane = F.lane;
    const bf16* QRAW = (const bf16*)(F.ws + WS_QRAW); bf16* Q = (bf16*)(F.ws + WS_Q); __half* QIDX = (__half*)(F.ws + WS_QIDX);
    for (int m = gw; m < TT; m += NGW) {
        const int t = m & (SEQ - 1); const float pos = (float)t;
        { const int hd = lane >> 3, d0 = (lane & 7) * 4; const v2u w1 = *(const GAS v2u*)(QRAW + (size_t)m * 768 + hd * 64 + d0), w2 = *(const GAS v2u*)(QRAW + (size_t)m * 768 + hd * 64 + d0 + 32);
          float x1[4] = {bflo(w1.x), bfhi(w1.x), bflo(w1.y), bfhi(w1.y)}, x2[4] = {bflo(w2.x), bfhi(w2.x), bflo(w2.y), bfhi(w2.y)}; float o1[4], o2[4];
#pragma unroll
          for (int i = 0; i < 4; ++i) { float c, s; rope_cs(pos, A.invf_att[d0 + i], c, s); o1[i] = (x1[i] * c - x2[i] * s) * C2; o2[i] = (x2[i] * c + x1[i] * s) * C2; }
          v2u a, b; a.x = pk2(o1[0], o1[1]); a.y = pk2(o1[2], o1[3]); b.x = pk2(o2[0], o2[1]); b.y = pk2(o2[2], o2[3]);
          *(GAS v2u*)(Q + (size_t)m * 512 + hd * 64 + d0) = a; *(GAS v2u*)(Q + (size_t)m * 512 + hd * 64 + d0 + 32) = b; }
        { const int hd = lane >> 4, i = lane & 15; const bf16* src = QRAW + (size_t)m * 768 + 512 + hd * 64; __half* dst = QIDX + (size_t)m * 256 + hd * 64;
          const float x1 = bf2f(src[i]), x2 = bf2f(src[i + 16]); float c, s; rope_cs(pos, A.invf_idx[i], c, s);
          dst[i] = __float2half(x1 * c - x2 * s); dst[i + 16] = __float2half(x2 * c + x1 * s);
          dst[32 + 2 * i] = __float2half(bf2f(src[32 + 2 * i])); dst[33 + 2 * i] = __float2half(bf2f(src[33 + 2 * i])); }
    }
}

__device__ __forceinline__ unsigned sortable(float x) { const unsigned u = __builtin_bit_cast(unsigned, x); return (u & 0x80000000u) ? ~u : (u | 0x80000000u); }
__device__ __forceinline__ void p_dsa_naive(Frame& F, const Args& A, int first_blk, int nblk) {
    const int tid = F.tid, lane = F.lane, wave = F.wave;
    const bf16* Q = (const bf16*)(F.ws + WS_Q); const bf16* KATT = (const bf16*)(F.ws + WS_KATT); const bf16* VATT = (const bf16*)(F.ws + WS_VATT);
    const __half* QIDX = (const __half*)(F.ws + WS_QIDX); const __half* KIDX = (const __half*)(F.ws + WS_KIDX); const float* SPEC = (const float*)(F.ws + WS_SPEC);
    unsigned long long* MASK = (unsigned long long*)(F.ws + WS_MASK); bf16* CAT = (bf16*)(F.ws + WS_CAT);
    LAS float* qi = (LAS float*)(F.lds);
    LAS float* wv = (LAS float*)(F.lds + 1024);
    LAS int* cntb = (LAS int*)(F.lds + 1280);
    LAS unsigned long long* mw = (LAS unsigned long long*)(F.lds + 2048);
    LAS int* pref = (LAS int*)(F.lds + 4096);
    LAS int* sel = (LAS int*)(F.lds + 8192);
    LAS float* P = (LAS float*)(F.lds + 16384);
    int par = 0;
    for (int m = F.bid - first_blk; m < TT; m += nblk) {
        const int b = m >> 13, t = m & (SEQ - 1);
        __syncthreads();
        if (tid < 256) qi[tid] = __half2float(QIDX[(size_t)m * 256 + tid]);
        if (tid < 4) wv[tid] = SPEC[(size_t)m * 128 + 64 + tid];
        __syncthreads();
        unsigned key[16];
#pragma unroll
        for (int j = 0; j < 16; ++j) { const int s = tid + 512 * j; key[j] = 0u;
            if (s <= t) { const v4u* kp = (const v4u*)(KIDX + ((size_t)b * SEQ + s) * 64); float d0 = 0.f, d1 = 0.f, d2 = 0.f, d3 = 0.f;
#pragma unroll
                for (int c = 0; c < 8; ++c) { const v4u w = kp[c]; const unsigned ww[4] = {w.x, w.y, w.z, w.w};
#pragma unroll
                    for (int e = 0; e < 4; ++e) { const __half2 h2 = __builtin_bit_cast(__half2, ww[e]); const float k0 = __low2float(h2), k1 = __high2float(h2); const int d = c * 8 + e * 2;
                        d0 += qi[d] * k0 + qi[d + 1] * k1; d1 += qi[64 + d] * k0 + qi[64 + d + 1] * k1; d2 += qi[128 + d] * k0 + qi[128 + d + 1] * k1; d3 += qi[192 + d] * k0 + qi[192 + d + 1] * k1; } }
                const float sc = wv[0] * fmaxf(d0, 0.f) + wv[1] * fmaxf(d1, 0.f) + wv[2] * fmaxf(d2, 0.f) + wv[3] * fmaxf(d3, 0.f);
                key[j] = sortable(sc); } }
#define BCOUNT(PRED, OUT) do { int c_ = 0; _Pragma("unroll") for (int j = 0; j < 16; ++j) { const int s = tid + 512 * j; (void)s; c_ += (int)__popcll(__ballot(PRED)); } \
            if (lane == 0) cntb[par * 8 + wave] = c_; __syncthreads(); int t_ = 0; _Pragma("unroll") for (int w_ = 0; w_ < 8; ++w_) t_ += cntb[par * 8 + w_]; par ^= 1; OUT = t_; } while (0)
        unsigned vstar = 1u; int cutoff = SEQ;
        if (t + 1 > TOPK) {
            unsigned cur = 0u;
            for (int bit = 31; bit >= 0; --bit) { const unsigned v = cur | (1u << bit); int c; BCOUNT(key[j] >= v, c); if (c >= TOPK) cur = v; }
            vstar = cur; int cgt; BCOUNT(key[j] > vstar, cgt); const int need = TOPK - cgt;
            int lo = 0, hi = SEQ - 1;
            while (lo < hi) { const int mid = (lo + hi) >> 1; int c; BCOUNT(key[j] == vstar && s <= mid, c); if (c >= need) hi = mid; else lo = mid + 1; }
            cutoff = lo;
        }
        bool selj[16];
#pragma unroll
        for (int j = 0; j < 16; ++j) { const int s = tid + 512 * j; selj[j] = (t + 1 > TOPK) ? (key[j] > vstar || (key[j] == vstar && s <= cutoff)) : (s <= t);
            const unsigned long long bm = __ballot(selj[j]); if (lane == 0) { mw[8 * j + wave] = bm; MASK[(size_t)m * 128 + 8 * j + wave] = bm; } }
        __syncthreads();
        if (wave == 0) { int c0 = (int)__popcll(mw[2 * lane]), c1 = (int)__popcll(mw[2 * lane + 1]); int s = c0 + c1, inc = s;
#pragma unroll
            for (int o = 1; o < 64; o <<= 1) { const int u = __shfl_up(inc, o); if (lane >= o) inc += u; }
            const int ex = inc - s; pref[2 * lane] = ex; pref[2 * lane + 1] = ex + c0; }
        __syncthreads();
#pragma unroll
        for (int j = 0; j < 16; ++j) if (selj[j]) { const int wd = 8 * j + wave; const int pos = pref[wd] + (int)__popcll(mw[wd] & ((1ull << lane) - 1ull)); if (pos < TOPK) sel[pos] = tid + 512 * j; }
        __syncthreads();
        const int nsel = (t + 1 < TOPK) ? t + 1 : TOPK;
        { const int h = wave; float qv[64];
          { const v4u* qp = (const v4u*)(Q + (size_t)m * 512 + h * 64);
#pragma unroll
            for (int c = 0; c < 8; ++c) { const v4u w = qp[c]; qv[8 * c] = bflo(w.x); qv[8 * c + 1] = bfhi(w.x); qv[8 * c + 2] = bflo(w.y); qv[8 * c + 3] = bfhi(w.y); qv[8 * c + 4] = bflo(w.z); qv[8 * c + 5] = bfhi(w.z); qv[8 * c + 6] = bflo(w.w); qv[8 * c + 7] = bfhi(w.w); } }
          float lg[4];
#pragma unroll
          for (int kk = 0; kk < 4; ++kk) { const int idx = lane + 64 * kk; lg[kk] = -INFINITY;
            if (idx < nsel) { const int s = sel[idx]; const v4u* kp = (const v4u*)(KATT + ((size_t)b * SEQ + s) * 512 + h * 64); float d = 0.f;
#pragma unroll
                for (int c = 0; c < 8; ++c) { const v4u w = kp[c]; d += qv[8 * c] * bflo(w.x) + qv[8 * c + 1] * bfhi(w.x) + qv[8 * c + 2] * bflo(w.y) + qv[8 * c + 3] * bfhi(w.y) + qv[8 * c + 4] * bflo(w.z) + qv[8 * c + 5] * bfhi(w.z) + qv[8 * c + 6] * bflo(w.w) + qv[8 * c + 7] * bfhi(w.w); }
                lg[kk] = d; } }
          const float mx = wave_max(fmaxf(fmaxf(lg[0], lg[1]), fmaxf(lg[2], lg[3]))); float ps = 0.f;
#pragma unroll
          for (int kk = 0; kk < 4; ++kk) { const float p = __builtin_amdgcn_exp2f(lg[kk] - mx); ps += p; P[h * 256 + lane + 64 * kk] = p; }
          const float tot = wave_sum(ps);
          LDS_WAIT(); asm volatile("" ::: "memory");
          float acc = 0.f;
          for (int idx = 0; idx < nsel; ++idx) { const int s = sel[idx]; acc += P[h * 256 + idx] * bf2f(VATT[((size_t)b * SEQ + s) * 512 + h * 64 + lane]); }
          CAT[(size_t)m * 1024 + h * 64 + lane] = (bf16)f2bf(acc / tot); }
    }
#undef BCOUNT
}

__device__ __forceinline__ void p_gdn_naive(Frame& F, const Args& A, int bh) {
    const int tid = F.tid, lane = F.lane, wave = F.wave; const int b = bh >> 2, h = bh & 3; const int e = tid & 127, ds = tid >> 7;
    const bf16* GQ = (const bf16*)(F.ws + WS_GQ); const bf16* GK = (const bf16*)(F.ws + WS_GK); const bf16* GV = (const bf16*)(F.ws + WS_GV); const bf16* GZ = (const bf16*)(F.ws + WS_GZ);
    const float* BETA = (const float*)(F.ws + WS_BETA); const float* GLOG = (const float*)(F.ws + WS_GLOG); bf16* CAT = (bf16*)(F.ws + WS_CAT);
    LAS float* red1 = (LAS float*)(F.lds + 65536); LAS float* red2 = (LAS float*)(F.lds + 65536 + 2048); LAS float* small = (LAS float*)(F.lds + 65536 + 4096);
    float S[32];
#pragma unroll
    for (int i = 0; i < 32; ++i) S[i] = 0.f;
    const float gout = A.in[I_GOUTG][e];
    for (int t = 0; t < SEQ; ++t) {
        const size_t row = (size_t)b * SEQ + t;
        float kk[32], qq[32];
        { const v4u* kp = (const v4u*)(GK + row * 512 + h * 128 + ds * 32); const v4u* qp = (const v4u*)(GQ + row * 512 + h * 128 + ds * 32);
#pragma unroll
          for (int c = 0; c < 4; ++c) { const v4u w = kp[c], u = qp[c];
            kk[8 * c] = bflo(w.x); kk[8 * c + 1] = bfhi(w.x); kk[8 * c + 2] = bflo(w.y); kk[8 * c + 3] = bfhi(w.y); kk[8 * c + 4] = bflo(w.z); kk[8 * c + 5] = bfhi(w.z); kk[8 * c + 6] = bflo(w.w); kk[8 * c + 7] = bfhi(w.w);
            qq[8 * c] = bflo(u.x); qq[8 * c + 1] = bfhi(u.x); qq[8 * c + 2] = bflo(u.y); qq[8 * c + 3] = bfhi(u.y); qq[8 * c + 4] = bflo(u.z); qq[8 * c + 5] = bfhi(u.z); qq[8 * c + 6] = bflo(u.w); qq[8 * c + 7] = bfhi(u.w); } }
        const float v = bf2f(GV[row * 512 + h * 128 + e]); const float beta = BETA[row * 4 + h]; const float a = __expf(GLOG[row * 4 + h]);
        float part = 0.f;
#pragma unroll
        for (int i = 0; i < 32; ++i) part += kk[i] * S[i];
        red1[ds * 128 + e] = part; __syncthreads();
        const float kS = (red1[e] + red1[128 + e]) + (red1[256 + e] + red1[384 + e]);
        const float vn = beta * (v - a * kS);
        float po = 0.f;
#pragma unroll
        for (int i = 0; i < 32; ++i) { S[i] = a * S[i] + kk[i] * vn; po += qq[i] * S[i]; }
        red2[ds * 128 + e] = po; __syncthreads();
        float o = 0.f;
        if (ds == 0) { o = ((red2[e] + red2[128 + e]) + (red2[256 + e] + red2[384 + e])) * 0.08838834764831845f; const float ss = wave_sum(o * o); if (lane == 0) small[wave] = ss; }
        __syncthreads();
        if (ds == 0) { const float rstd = 1.0f / sqrtf((small[0] + small[1]) * (1.f / 128) + NORM_EPS); const float z = bf2f(GZ[row * 512 + h * 128 + e]);
            CAT[row * 1024 + 512 + h * 128 + e] = (bf16)f2bf(o * rstd * gout * silu2(z)); }
    }
}

enum { PH_PRO = 0, PH_F1A, PH_F1B, PH_ROW1, PH_INPROJ, PH_PREP1, PH_QPROJ, PH_PREP2, PH_MIX, PH_OUTPROJ, PH_ROW2, PH_F2A, PH_F2B, PH_ROW3, PH_N };

__global__ void __launch_bounds__(NTHR, 2) mega_fwd(Args args) {
    extern __shared__ __attribute__((aligned(16))) unsigned char lds[];
    cg::grid_group grid = cg::this_grid();
    Frame F; F.lds = (LAS unsigned char*)lds; F.tid = threadIdx.x; F.lane = F.tid & 63; F.wave = __builtin_amdgcn_readfirstlane(F.tid >> 6); F.G = gridDim.x; F.bid = blockIdx.x; F.ws = args.ws;
    unsigned char* ws = args.ws;
    const int lo = args.ph_lo, hi = args.ph_hi;
#define IN(k) (lo <= (k) && (k) < hi)
#define SEAM(k) do { if (IN(k) && IN((k) + 1)) grid.sync(); } while (0)
    bf16* XN = (bf16*)(ws + WS_XN); bf16* FB = (bf16*)(ws + WS_FB); bf16* HID = (bf16*)(ws + WS_HID);

    if (IN(PH_PRO)) { p_prologue(F, args); } SEAM(PH_PRO);
    if (IN(PH_F1A)) { pg8::Gemm g{XN, (const bf16*)(ws + WS_W1A), TT, 2 * DFF, DM}; pg8::StaticOrder S; S.init(TT, 2 * DFF, F.G, F.bid); pg8::EpiSwiGLU E{HID, DFF};
        pg8::gemm_phase<pg8::EpiSwiGLU, pg8::StaticOrder, true, true>(F.lds, g, S, E); } SEAM(PH_F1A);
    if (IN(PH_F1B)) { pg8::Gemm g{HID, (const bf16*)(ws + WS_W1B), TT, DM, DFF}; pg8::StaticOrder S; S.init(TT, DM, F.G, F.bid); pg8::EpiPlain E{FB, DM};
        pg8::gemm_phase<pg8::EpiPlain, pg8::StaticOrder, true, true>(F.lds, g, S, E); } SEAM(PH_F1B);
    if (IN(PH_ROW1)) { p_rowpass(F, FB, args.in[I_X], args.in[I_F1POST], 0.5f, args.out, args.in[I_MPRE], XN); } SEAM(PH_ROW1);
    if (IN(PH_INPROJ)) { pg8::Gemm g{XN, (const bf16*)(ws + WS_WIN), TT, DINP, DM}; pg8::StaticOrder S; S.init(TT, DINP, F.G, F.bid);
        pg8::EpiInProj E{(bf16*)(ws + WS_CQ), (bf16*)(ws + WS_KATT), (bf16*)(ws + WS_VATT), (bf16*)(ws + WS_GRAW), (bf16*)(ws + WS_GZ), (float*)(ws + WS_SPEC)};
        pg8::gemm_phase<pg8::EpiInProj, pg8::StaticOrder, true, true>(F.lds, g, S, E); } SEAM(PH_INPROJ);
    if (IN(PH_PREP1)) { p_prep1(F, args); } SEAM(PH_PREP1);
    if (IN(PH_QPROJ)) { pg8::Gemm g{(const bf16*)(ws + WS_CQ), (const bf16*)(ws + WS_WQ), TT, 768, 256}; pg8::StaticOrder S; S.init(TT, 768, F.G, F.bid); pg8::EpiPlain E{(bf16*)(ws + WS_QRAW), 768};
        pg8::gemm_phase<pg8::EpiPlain, pg8::StaticOrder, true, true>(F.lds, g, S, E); } SEAM(PH_QPROJ);
    if (IN(PH_PREP2)) { p_prep2(F, args); } SEAM(PH_PREP2);
    if (IN(PH_MIX)) { if (F.bid < 8) p_gdn_naive(F, args, F.bid); else p_dsa_naive(F, args, 8, F.G - 8); } SEAM(PH_MIX);
    if (IN(PH_OUTPROJ)) { pg8::Gemm g{(const bf16*)(ws + WS_CAT), (const bf16*)(ws + WS_WOUT), TT, DM, DM}; pg8::StaticOrder S; S.init(TT, DM, F.G, F.bid); pg8::EpiPlain E{FB, DM};
        pg8::gemm_phase<pg8::EpiPlain, pg8::StaticOrder, true, true>(F.lds, g, S, E); } SEAM(PH_OUTPROJ);
    if (IN(PH_ROW2)) { p_rowpass(F, FB, args.out, args.in[I_MPOST], 1.0f, args.out, args.in[I_F2PRE], XN); } SEAM(PH_ROW2);
    if (IN(PH_F2A)) { pg8::Gemm g{XN, (const bf16*)(ws + WS_W2A), TT, 2 * DFF, DM}; pg8::StaticOrder S; S.init(TT, 2 * DFF, F.G, F.bid); pg8::EpiSwiGLU E{HID, DFF};
        pg8::gemm_phase<pg8::EpiSwiGLU, pg8::StaticOrder, true, true>(F.lds, g, S, E); } SEAM(PH_F2A);
    if (IN(PH_F2B)) { pg8::Gemm g{HID, (const bf16*)(ws + WS_W2B), TT, DM, DFF}; pg8::StaticOrder S; S.init(TT, DM, F.G, F.bid); pg8::EpiPlain E{FB, DM};
        pg8::gemm_phase<pg8::EpiPlain, pg8::StaticOrder, true, true>(F.lds, g, S, E); } SEAM(PH_F2B);
    if (IN(PH_ROW3)) { p_rowpass(F, FB, args.out, args.in[I_F2POST], 0.5f, args.out, nullptr, nullptr); }
#undef IN
#undef SEAM
}

extern "C" void kernel_launch(void* const* d_in, const int* in_sizes, int n_in, void* d_out, int out_size, void* d_ws, size_t ws_size, hipStream_t stream) {
    static int grid = 0;
    if (grid == 0) {
        if (n_in != 24 || out_size != TT * DM || ws_size < WS_END) { fprintf(stderr, "kernel_launch: unexpected shapes (n_in %d out %d ws %zu)\n", n_in, out_size, ws_size); grid = -1; return; }
        int dev = 0, cus = 0, per_cu = 0;
        hipGetDevice(&dev); hipDeviceGetAttribute(&cus, hipDeviceAttributeMultiprocessorCount, dev);
        if (hipFuncSetAttribute((const void*)mega_fwd, hipFuncAttributeMaxDynamicSharedMemorySize, LDS_BYTES) != hipSuccess) { fprintf(stderr, "kernel_launch: hipFuncSetAttribute failed\n"); grid = -1; return; }
        if (hipOccupancyMaxActiveBlocksPerMultiprocessor(&per_cu, (const void*)mega_fwd, NTHR, LDS_BYTES) != hipSuccess || per_cu < 1) { fprintf(stderr, "kernel_launch: occupancy query says %d\n", per_cu); per_cu = 1; }
        (void)hipGetLastError();
        grid = cus * (per_cu < 1 ? 1 : 1);
        fprintf(stderr, "kernel_launch: cus %d per_cu %d grid %d\n", cus, per_cu, grid);
    }
    if (grid < 0) return;
    Args a{};
    for (int i = 0; i < 24; ++i) a.in[i] = (const float*)d_in[i];
    a.out = (float*)d_out; a.ws = (unsigned char*)d_ws;
    for (int i = 0; i < 32; ++i) a.invf_att[i] = 1.0f / powf(10000.0f, (float)i / 32.0f);
    for (int i = 0; i < 16; ++i) a.invf_idx[i] = 1.0f / powf(10000.0f, (float)i / 16.0f);
    a.ph_lo = 0; a.ph_hi = PH_N;
    void* kargs[] = {&a};
    hipError_t e = hipLaunchCooperativeKernel((const void*)mega_fwd, dim3(grid), dim3(NTHR), kargs, LDS_BYTES, stream);
    if (e != hipSuccess) fprintf(stderr, "kernel_launch: cooperative launch failed: %s (grid %d)\n", hipGetErrorString(e), grid);
}
```

```cpp
#include <hip/hip_runtime.h>
#include <hip/hip_cooperative_groups.h>
#include <hip/hip_bf16.h>
#include <hip/hip_fp16.h>
#include <cstdio>
#include <cstdint>
#include <cmath>
namespace cg = cooperative_groups;
namespace pg8 {
#define PG8_LAS __attribute__((address_space(3)))
typedef unsigned short bf16_t;
typedef short bf16x8 __attribute__((ext_vector_type(8)));
typedef float f32x4 __attribute__((ext_vector_type(4)));
typedef unsigned u32x4 __attribute__((ext_vector_type(4)));
constexpr int BM = 256, BK = 64, HALF = 128, HTB = HALF * BK * 2  , STAGE_BYTES = 8 * HTB, NXCD = 8, WGM = 8;

__host__ __device__ __forceinline__ int lds_byte(int r, int c) { const int st = (r >> 4) * 2 + (c >> 5), rr = r & 15, cc = c & 31, ob = rr * 64 + cc * 2; return st * 1024 + (ob ^ (((ob >> 9) & 1) << 5)); }
__host__ __device__ __forceinline__ void stage_rc(int b, int& R, int& C) { const int st = b / 1024, sb = b % 1024, swz = sb ^ (((sb >> 9) & 1) << 5); R = (st >> 1) * 16 + swz / 64; C = (st & 1) * 32 + (swz % 64) / 2; }
__host__ __device__ __forceinline__ int perm32(int rho) { const int n = rho >> 4, i = rho & 15; return 8 * (i >> 2) + 4 * n + (i & 3); }

struct Unit { int pm, pn; };
struct Gemm { const bf16_t* A; const bf16_t* Bt; int M, N, K; };

struct StaticOrder {
    int nM, nN, nwg, G, c;
    __host__ __device__ void init(int M, int N, int G_, int c_) { nM = M / BM; nN = N / BM; nwg = nM * nN; G = G_; c = c_; }
    __host__ __device__ bool next(int i, Unit& u) const {
        const long L = (long)i * G + c; if (L >= nwg) return false;
        int wgid = (int)L; { const int q = nwg / NXCD, r = nwg % NXCD, xcd = wgid % NXCD, off = wgid / NXCD; wgid = (xcd < r ? xcd * (q + 1) : r * (q + 1) + (xcd - r) * q) + off; }
        const int nig = WGM * nN, gid = wgid / nig, fm = gid * WGM, gsz = (nM - fm) < WGM ? (nM - fm) : WGM;
        u.pm = fm + ((wgid % nig) % gsz); u.pn = (wgid % nig) / gsz; return true;
    }
    __device__ __forceinline__ void a_ready(const Unit&) const {}
    __device__ __forceinline__ void done(const Unit&) const {}
};

__device__ __forceinline__ unsigned cvt_pk_bf16(float lo, float hi) { unsigned r; asm volatile("v_cvt_pk_bf16_f32 %0, %1, %2" : "=v"(r) : "v"(lo), "v"(hi)); return r; }
typedef float f32x2 __attribute__((ext_vector_type(2)));
__device__ __forceinline__ u32x4 pack8(const f32x4 v0, const f32x4 v1) { u32x4 w; w.x = cvt_pk_bf16(v0[0], v0[1]); w.y = cvt_pk_bf16(v0[2], v0[3]); w.z = cvt_pk_bf16(v1[0], v1[1]); w.w = cvt_pk_bf16(v1[2], v1[3]); return w; }
struct EpiPlain {
    static constexpr bool PERM = true, AFTER_DRAIN = false;
    bf16_t* O; int ldc;
    __device__ __forceinline__ void operator()(const f32x4 (&acc)[2][2][4][2], const Unit& u, int wr, int wc, int fr, int fq) const {
        const int row0 = u.pm * BM + wr * 64 + fr, col0 = u.pn * BM + wc * 32 + 8 * fq;
#pragma unroll
        for (int ai = 0; ai < 2; ++ai)
#pragma unroll
            for (int m = 0; m < 4; ++m) { bf16_t* rowp = O + (size_t)(row0 + ai * HALF + m * 16) * ldc + col0;
#pragma unroll
                for (int bj = 0; bj < 2; ++bj) *(u32x4*)(rowp + bj * HALF) = pack8(acc[ai][bj][m][0], acc[ai][bj][m][1]); }
    }
};
__device__ __forceinline__ float silu_f(float g) { return g * __builtin_amdgcn_rcpf(1.0f + __builtin_amdgcn_exp2f(-1.4426950408889634f * g)); }
struct EpiSwiGLU {
    static constexpr bool PERM = true, AFTER_DRAIN = false;
    bf16_t* H; int ldh;
    __device__ __forceinline__ void operator()(const f32x4 (&acc)[2][2][4][2], const Unit& u, int wr, int wc, int fr, int fq) const {
        const int row0 = u.pm * BM + wr * 64 + fr, col0 = u.pn * HALF + wc * 32 + 8 * fq;
#pragma unroll
        for (int ai = 0; ai < 2; ++ai)
#pragma unroll
            for (int m = 0; m < 4; ++m) { bf16_t* rowp = H + (size_t)(row0 + ai * HALF + m * 16) * ldh + col0;
                f32x4 h0, h1;
#pragma unroll
                for (int i = 0; i < 4; ++i) { h0[i] = silu_f(acc[ai][0][m][0][i]) * acc[ai][1][m][0][i]; h1[i] = silu_f(acc[ai][0][m][1][i]) * acc[ai][1][m][1][i]; }
                *(u32x4*)rowp = pack8(h0, h1); }
    }
};
struct EpiInProj {
    static constexpr bool PERM = true, AFTER_DRAIN = false;
    bf16_t *CQ, *KATT, *VATT, *GRAW, *GZ; float* SPEC;
    __device__ __forceinline__ void operator()(const f32x4 (&acc)[2][2][4][2], const Unit& u, int wr, int wc, int fr, int fq) const {
        const int row0 = u.pm * BM + wr * 64 + fr; const int pn = u.pn;
        if (pn == 13) {
            const int col0 = wc * 32 + 8 * fq;
#pragma unroll
            for (int ai = 0; ai < 2; ++ai)
#pragma unroll
                for (int m = 0; m < 4; ++m) { float* rowp = SPEC + (size_t)(row0 + ai * HALF + m * 16) * 128 + col0;
                    *(f32x4*)rowp = acc[ai][0][m][0]; *(f32x4*)(rowp + 4) = acc[ai][0][m][1]; }
            return;
        }
        bf16_t* base; int ldc, ct;
        if (pn == 0) { base = CQ; ldc = 256; ct = 0; }
        else if (pn < 3) { base = KATT; ldc = 512; ct = (pn - 1) * 256; }
        else if (pn < 5) { base = VATT; ldc = 512; ct = (pn - 3) * 256; }
        else if (pn < 11) { base = GRAW; ldc = 1536; ct = (pn - 5) * 256; }
        else { base = GZ; ldc = 512; ct = (pn - 11) * 256; }
        const int col0 = ct + wc * 32 + 8 * fq;
#pragma unroll
        for (int ai = 0; ai < 2; ++ai)
#pragma unroll
            for (int m = 0; m < 4; ++m) { bf16_t* rowp = base + (size_t)(row0 + ai * HALF + m * 16) * ldc + col0;
#pragma unroll
                for (int bj = 0; bj < 2; ++bj) *(u32x4*)(rowp + bj * HALF) = pack8(acc[ai][bj][m][0], acc[ai][bj][m][1]); }
    }
};
template <class Epi, class Sched, bool ALIGN_EPI = false, bool SP2 = false>
__device__ __forceinline__ void gemm_phase(PG8_LAS unsigned char* lds, const Gemm g, const Sched& S, const Epi& E) {
    const int tid = threadIdx.x, wid = __builtin_amdgcn_readfirstlane(tid >> 6), lane = tid & 63, wr = wid >> 2, wc = wid & 3, fr = lane & 15, fq = lane >> 4;
    const int K = g.K, nt = K / BK;
    unsigned voffA[2], voffB[2];
#pragma unroll
    for (int i = 0; i < 2; ++i) { int R, C; stage_rc(tid * 16 + i * 8192, R, C); const int Rb = Epi::PERM ? ((R & ~31) + perm32(R & 31)) : R;
        voffA[i] = (unsigned)(R * K + C) * 2u; voffB[i] = (unsigned)(Rb * K + C) * 2u; }
    const size_t kstep = (size_t)(BK * 2);
    const size_t hstep = (size_t)HALF * K * 2;
    const size_t tstep = 2 * hstep;
    const unsigned ldsw = (unsigned)wid * 1024u;
    const int aoff = lds_byte(wr * 64 + fr, fq * 8), boff = lds_byte(wc * 32 + fr, fq * 8);
#define PG8_SA(b, h) (((b) * 2 + (h)) * HTB)
#define PG8_SB(b, h) ((4 + (b) * 2 + (h)) * HTB)
#define PG8_STAGE(bufoff, gbase, voff) do { _Pragma("unroll") for (int _i = 0; _i < 2; ++_i) \
        __builtin_amdgcn_global_load_lds((const unsigned*)((const char*)(gbase) + (voff)[_i]), (PG8_LAS unsigned*)(lds + (bufoff) + ldsw + _i * 8192), 16, 0, 0); } while (0)
#define PG8_LDA(dst, b, h) do { _Pragma("unroll") for (int m = 0; m < 4; ++m) _Pragma("unroll") for (int k = 0; k < 2; ++k) dst[m][k] = *(const PG8_LAS bf16x8*)(lds + PG8_SA(b, h) + aoff + m * 2048 + k * 1024); } while (0)
#define PG8_LDB(dst, b, h) do { _Pragma("unroll") for (int n = 0; n < 2; ++n) _Pragma("unroll") for (int k = 0; k < 2; ++k) dst[n][k] = *(const PG8_LAS bf16x8*)(lds + PG8_SB(b, h) + boff + n * 2048 + k * 1024); } while (0)
#define PG8_MMA(ai, bj, At, Bt) do { __builtin_amdgcn_s_setprio(1); _Pragma("unroll") for (int m = 0; m < 4; ++m) _Pragma("unroll") for (int n = 0; n < 2; ++n) _Pragma("unroll") for (int k = 0; k < 2; ++k) \
        acc[ai][bj][m][n] = __builtin_amdgcn_mfma_f32_16x16x32_bf16(Bt[n][k], At[m][k], acc[ai][bj][m][n], 0, 0, 0); __builtin_amdgcn_s_setprio(0); } while (0)
#define PG8_WAIT_V(n) asm volatile("s_waitcnt vmcnt(" #n ")" ::: "memory")
#define PG8_WAIT_L(n) asm volatile("s_waitcnt lgkmcnt(" #n ")" ::: "memory")
#define PG8_BAR __builtin_amdgcn_s_barrier()
#define PG8_SCHED __builtin_amdgcn_sched_barrier(0)
    Unit cur, nxt; int ui = 0;
    if (!S.next(0, cur)) return;
    f32x4 acc[2][2][4][2];
#pragma unroll
    for (int a = 0; a < 2; ++a)
#pragma unroll
        for (int b = 0; b < 2; ++b)
#pragma unroll
            for (int m = 0; m < 4; ++m)
#pragma unroll
                for (int n = 0; n < 2; ++n) acc[a][b][m][n] = (f32x4){0.f, 0.f, 0.f, 0.f};
    bf16x8 At[4][2], B0[2][2], B1[2][2];
    const char* cA = (const char*)g.A + (size_t)cur.pm * tstep; const char* cB = (const char*)g.Bt + (size_t)cur.pn * tstep;
    S.a_ready(cur);
    if constexpr (SP2) {
        PG8_STAGE(PG8_SB(0, 0), cB, voffB); PG8_STAGE(PG8_SB(0, 1), cB + hstep, voffB); PG8_STAGE(PG8_SA(0, 0), cA, voffA); PG8_STAGE(PG8_SA(0, 1), cA + hstep, voffA);
        if (wr == 1) PG8_BAR;
        PG8_WAIT_V(2); PG8_BAR;
        PG8_STAGE(PG8_SB(1, 0), cB + kstep, voffB); PG8_STAGE(PG8_SA(1, 0), cA + kstep, voffA); PG8_STAGE(PG8_SB(1, 1), cB + hstep + kstep, voffB);
        PG8_WAIT_V(6); PG8_BAR;
    } else {
        PG8_STAGE(PG8_SB(0, 0), cB, voffB); PG8_STAGE(PG8_SA(0, 0), cA, voffA); PG8_STAGE(PG8_SB(0, 1), cB + hstep, voffB); PG8_STAGE(PG8_SA(0, 1), cA + hstep, voffA);
        if (wr == 1) PG8_BAR;
        PG8_WAIT_V(4); PG8_BAR;
        PG8_STAGE(PG8_SB(1, 0), cB + kstep, voffB); PG8_STAGE(PG8_SA(1, 0), cA + kstep, voffA); PG8_STAGE(PG8_SB(1, 1), cB + hstep + kstep, voffB);
        PG8_WAIT_V(6); PG8_BAR;
    }
    for (;;) {
        const bool has_next = S.next(ui + 1, nxt);
        const char* nA = has_next ? (const char*)g.A + (size_t)nxt.pm * tstep : cA; const char* nB = has_next ? (const char*)g.Bt + (size_t)nxt.pn * tstep : cB;
        for (int t = 0; t < nt; t += 2) {
            const bool last = (t == nt - 2);
            const char* a1 = cA + (size_t)(t + 1) * kstep;
            const char* a2 = last ? nA : cA + (size_t)(t + 2) * kstep; const char* b2 = last ? nB : cB + (size_t)(t + 2) * kstep;
            const char* a3 = a2 + kstep; const char* b3 = b2 + kstep;
            if (last && has_next) S.a_ready(nxt);
            if constexpr (SP2) {
            PG8_LDB(B0, 0, 0); PG8_LDB(B1, 0, 1); PG8_SCHED; PG8_LDA(At, 0, 0); PG8_STAGE(PG8_SA(1, 1), a1 + hstep, voffA);
            PG8_WAIT_V(8); PG8_WAIT_L(0); PG8_BAR; PG8_MMA(0, 0, At, B0); PG8_MMA(0, 1, At, B1); PG8_BAR; PG8_SCHED;
            PG8_LDA(At, 0, 1); PG8_STAGE(PG8_SB(0, 0), b2, voffB); PG8_STAGE(PG8_SB(0, 1), b2 + hstep, voffB); PG8_STAGE(PG8_SA(0, 0), a2, voffA);
            PG8_WAIT_V(8); PG8_WAIT_L(0); PG8_BAR; PG8_MMA(1, 0, At, B0); PG8_MMA(1, 1, At, B1); PG8_BAR; PG8_SCHED;
            PG8_LDB(B0, 1, 0); PG8_LDB(B1, 1, 1); PG8_SCHED; PG8_LDA(At, 1, 0); PG8_STAGE(PG8_SA(0, 1), a2 + hstep, voffA);
            PG8_WAIT_V(8); PG8_WAIT_L(0); PG8_BAR; PG8_MMA(0, 0, At, B0); PG8_MMA(0, 1, At, B1); PG8_BAR; PG8_SCHED;
            PG8_LDA(At, 1, 1); PG8_STAGE(PG8_SB(1, 0), b3, voffB); PG8_STAGE(PG8_SB(1, 1), b3 + hstep, voffB); PG8_STAGE(PG8_SA(1, 0), a3, voffA);
            PG8_WAIT_V(8); PG8_WAIT_L(0); PG8_BAR; PG8_MMA(1, 0, At, B0); PG8_MMA(1, 1, At, B1); PG8_BAR; PG8_SCHED;
            } else {
            PG8_LDB(B0, 0, 0); PG8_SCHED; PG8_LDA(At, 0, 0); PG8_STAGE(PG8_SA(1, 1), a1 + hstep, voffA);
            PG8_WAIT_L(8); PG8_BAR; PG8_WAIT_L(0); PG8_MMA(0, 0, At, B0); PG8_BAR; PG8_SCHED;
            PG8_LDB(B1, 0, 1); PG8_STAGE(PG8_SB(0, 0), b2, voffB);
            PG8_BAR; PG8_WAIT_L(0); PG8_MMA(0, 1, At, B1); PG8_BAR;
            PG8_LDA(At, 0, 1); PG8_STAGE(PG8_SA(0, 0), a2, voffA);
            PG8_BAR; PG8_WAIT_L(0); PG8_MMA(1, 0, At, B0); PG8_BAR; PG8_SCHED;
            PG8_STAGE(PG8_SB(0, 1), b2 + hstep, voffB);
            PG8_WAIT_V(6); PG8_BAR; PG8_MMA(1, 1, At, B1); PG8_BAR;
            PG8_LDB(B0, 1, 0); PG8_SCHED; PG8_LDA(At, 1, 0); PG8_STAGE(PG8_SA(0, 1), a2 + hstep, voffA);
            PG8_WAIT_L(8); PG8_BAR; PG8_WAIT_L(0); PG8_MMA(0, 0, At, B0); PG8_BAR; PG8_SCHED;
            PG8_LDB(B1, 1, 1); PG8_STAGE(PG8_SB(1, 0), b3, voffB);
            PG8_BAR; PG8_WAIT_L(0); PG8_MMA(0, 1, At, B1); PG8_BAR;
            PG8_LDA(At, 1, 1); PG8_STAGE(PG8_SA(1, 0), a3, voffA);
            PG8_BAR; PG8_WAIT_L(0); PG8_MMA(1, 0, At, B0); PG8_BAR; PG8_SCHED;
            PG8_STAGE(PG8_SB(1, 1), b3 + hstep, voffB);
            PG8_WAIT_V(6); PG8_BAR; PG8_MMA(1, 1, At, B1); PG8_BAR;
            }
        }
        if constexpr (ALIGN_EPI) { if (wr == 0) PG8_BAR; }
        if constexpr (!Epi::AFTER_DRAIN) { E(acc, cur, wr, wc, fr, fq); S.done(cur); }
        if (!has_next) break;
#pragma unroll
        for (int a = 0; a < 2; ++a)
#pragma unroll
            for (int b = 0; b < 2; ++b)
#pragma unroll
                for (int m = 0; m < 4; ++m)
#pragma unroll
                    for (int n = 0; n < 2; ++n) acc[a][b][m][n] = (f32x4){0.f, 0.f, 0.f, 0.f};
        cur = nxt; cA = nA; cB = nB; ++ui;
        if constexpr (ALIGN_EPI) { if (wr == 1) PG8_BAR; }
    }
    PG8_WAIT_V(0);
    if constexpr (!ALIGN_EPI) { if (wr == 0) PG8_BAR; }
    PG8_BAR;
    if constexpr (Epi::AFTER_DRAIN) { E.fused(acc, cur, wr, wc, fr, fq, lds, wid, lane); S.done(cur); }
#undef PG8_SA
#undef PG8_SB
#undef PG8_STAGE
#undef PG8_LDA
#undef PG8_LDB
#undef PG8_MMA
#undef PG8_WAIT_V
#undef PG8_WAIT_L
#undef PG8_BAR
#undef PG8_SCHED
}
}
constexpr int NWAVES = 8, NTHR = 512;
constexpr int BATCH = 2, SEQ = 8192, TT = BATCH * SEQ, DM = 1024, DFF = 2816, DIN = 3404, DINP = 3584;
constexpr int TOPK = 256;
constexpr float NORM_EPS = 1e-6f;
constexpr float C2 = 0.125f * 1.4426950408889634f;
constexpr size_t MiB = 1u << 20;
constexpr size_t WS_CTL = 0, CTL_ZERO_BYTES = 1 * MiB;
constexpr size_t WS_WA = 1 * MiB, WS_WB = 12 * MiB, WS_WIN = 35 * MiB / 2, WS_WQ = 49 * MiB / 2, WS_WOUT = 25 * MiB;
constexpr size_t WS_BETA = 27 * MiB, WS_GLOG = 27 * MiB + MiB / 4, WS_WIDX = 27 * MiB + MiB / 2, WS_GF = 27 * MiB + 3 * MiB / 4, WS_KIDX = 29 * MiB;
constexpr size_t WS_XN = 32 * MiB, WS_FB = 64 * MiB, WS_HID = 96 * MiB;
constexpr size_t WS_CQ = 64 * MiB, WS_KATT = 72 * MiB, WS_VATT = 88 * MiB, WS_GRAW = 104 * MiB, WS_GZ = 152 * MiB, WS_SPEC = 168 * MiB;
constexpr size_t WS_QF = 176 * MiB, WS_KF = 192 * MiB, WS_KTF = 208 * MiB, WS_VTF = 224 * MiB;
constexpr size_t WS_QRAW = 104 * MiB, WS_Q = 32 * MiB, WS_QIDX = 48 * MiB;
constexpr size_t WS_MASK = 240 * MiB, WS_CAT = 104 * MiB;
constexpr size_t WS_WF = 136 * MiB, WS_UC = 1 * MiB, WS_QKF = 17 * MiB;
constexpr size_t WS_END = 256 * MiB;
constexpr int RING_BYTES = 131072, LDS_BYTES = 151552;

#define GAS __attribute__((address_space(1)))
#define LAS __attribute__((address_space(3)))
typedef unsigned short bf16;
typedef unsigned v4u __attribute__((ext_vector_type(4)));
typedef unsigned v2u __attribute__((ext_vector_type(2)));
typedef float f32x4 __attribute__((ext_vector_type(4)));
#define LDS_WAIT() asm volatile("s_waitcnt lgkmcnt(0)" ::: "memory")

__device__ __forceinline__ unsigned f2bf(float f) { unsigned u = __builtin_bit_cast(unsigned, f); return (u + 0x7fffu + ((u >> 16) & 1u)) >> 16; }
__device__ __forceinline__ unsigned pk2(float lo, float hi) { return f2bf(lo) | (f2bf(hi) << 16); }
__device__ __forceinline__ float bf2f(unsigned short h) { return __builtin_bit_cast(float, (unsigned)h << 16); }
__device__ __forceinline__ float bflo(unsigned w) { return __builtin_bit_cast(float, w << 16); }
__device__ __forceinline__ float bfhi(unsigned w) { return __builtin_bit_cast(float, w & 0xffff0000u); }
#define SWZ_XOR(x_, m_) __builtin_bit_cast(float, __builtin_amdgcn_ds_swizzle(__builtin_bit_cast(int, (x_)), (((m_) << 10) | 0x1f)))
__device__ __forceinline__ float xor32f(float v) { auto rr = __builtin_amdgcn_permlane32_swap(__builtin_bit_cast(unsigned, v), __builtin_bit_cast(unsigned, v), false, false); return __builtin_bit_cast(float, (unsigned)(rr[0] ^ rr[1] ^ __builtin_bit_cast(unsigned, v))); }
__device__ __forceinline__ float wave_sum(float v) {
    v += SWZ_XOR(v, 1); v += SWZ_XOR(v, 2); v += SWZ_XOR(v, 4); v += SWZ_XOR(v, 8); v += SWZ_XOR(v, 16);
    auto rr = __builtin_amdgcn_permlane32_swap(__builtin_bit_cast(unsigned, v), __builtin_bit_cast(unsigned, v), false, false);
    return __builtin_bit_cast(float, (unsigned)rr[0]) + __builtin_bit_cast(float, (unsigned)rr[1]);
}
__device__ __forceinline__ float wave_max(float v) {
    v = fmaxf(v, SWZ_XOR(v, 1)); v = fmaxf(v, SWZ_XOR(v, 2)); v = fmaxf(v, SWZ_XOR(v, 4)); v = fmaxf(v, SWZ_XOR(v, 8)); v = fmaxf(v, SWZ_XOR(v, 16));
    auto rr = __builtin_amdgcn_permlane32_swap(__builtin_bit_cast(unsigned, v), __builtin_bit_cast(unsigned, v), false, false);
    return fmaxf(__builtin_bit_cast(float, (unsigned)rr[0]), __builtin_bit_cast(float, (unsigned)rr[1]));
}
__device__ __forceinline__ float sigmoid_f(float x) { return __builtin_amdgcn_rcpf(1.0f + __builtin_amdgcn_exp2f(-1.4426950408889634f * x)); }
__device__ __forceinline__ float silu2(float x) { return x * sigmoid_f(x); }
__device__ __forceinline__ void rope_cs(float pos, float invf, float& c, float& s) {
    const float ang = pos * invf; double rev = (double)ang * 0.15915494309189535; rev -= __builtin_floor(rev); const float r = (float)rev;
    s = __builtin_amdgcn_sinf(r); c = __builtin_amdgcn_cosf(r);
}

struct Args { const float* in[24]; float* out; unsigned char* ws; float invf_att[32]; float invf_idx[16]; int ph_lo, ph_hi; };
enum { I_X = 0, I_F1PRE, I_F1POST, I_F1G, I_F1U, I_F1D, I_MPRE, I_MPOST, I_WIN, I_QAG, I_WQB, I_WQIB, I_KLG, I_KLB, I_CONV, I_ALOG, I_DTB, I_GOUTG, I_WOUT, I_F2PRE, I_F2POST, I_F2G, I_F2U, I_F2D };

struct Frame {
    LAS unsigned char* lds;
    int tid, lane, wave, G, bid;
    unsigned char* ws;
};

__device__ __forceinline__ void transpose_item(const float* W, int Nsrc, int K, bf16* WT, int n0, int sc, int k0, LAS float* scr, int lane) {
#pragma unroll 8
    for (int i = 0; i < 32; ++i) { const int kk = 2 * i + (lane >> 5); scr[kk * 33 + (lane & 31)] = sc >= 0 ? W[(size_t)(k0 + kk) * Nsrc + sc] : 0.f; }
    LDS_WAIT(); asm volatile("" ::: "memory");
    const int c = lane & 7;
#pragma unroll
    for (int j = 0; j < 4; ++j) { const int n = (lane >> 3) + 8 * j; const LAS float* s = scr + (8 * c) * 33 + n;
        v4u o; o.x = pk2(s[0 * 33], s[1 * 33]); o.y = pk2(s[2 * 33], s[3 * 33]); o.z = pk2(s[4 * 33], s[5 * 33]); o.w = pk2(s[6 * 33], s[7 * 33]);
        *(GAS v4u*)(WT + (size_t)(n0 + n) * K + k0 + 8 * c) = o; }
    LDS_WAIT(); asm volatile("" ::: "memory");
}
__device__ __forceinline__ int inproj_src(int r) {
    if (r < 1280) return r;
    if (r < 3328) return r + 68;
    if (r < 3392) return 1280 + (r - 3328);
    if (r < 3396) return 1344 + (r - 3392);
    if (r < 3404) return r;
    return -1;
}
__device__ __forceinline__ void rms_row_to_bf16(const float* xrow, const float* g, bf16* orow, int lane) {
    const GAS f32x4* xr = (const GAS f32x4*)xrow + lane; const GAS f32x4* gr = (const GAS f32x4*)g + lane;
    f32x4 v[4]; float s = 0.f;
#pragma unroll
    for (int j = 0; j < 4; ++j) { v[j] = xr[64 * j]; s += (v[j].x * v[j].x + v[j].y * v[j].y) + (v[j].z * v[j].z + v[j].w * v[j].w); }
    const float rstd = 1.0f / sqrtf(wave_sum(s) * (1.f / DM) + NORM_EPS);
    GAS v2u* o8 = (GAS v2u*)orow + lane;
#pragma unroll
    for (int j = 0; j < 4; ++j) { const f32x4 gg = gr[64 * j]; v2u o; o.x = pk2(v[j].x * rstd * gg.x, v[j].y * rstd * gg.y); o.y = pk2(v[j].z * rstd * gg.z, v[j].w * rstd * gg.w); o8[64 * j] = o; }
}
__device__ __forceinline__ void conv_ffn_weights(Frame& F, const Args& A, int f) {
    LAS float* scr = (LAS float*)(F.lds + F.wave * 16384);
    const int gw = F.bid * NWAVES + F.wave, NGW = F.G * NWAVES, lane = F.lane;
    bf16* WA = (bf16*)(F.ws + WS_WA); bf16* WB = (bf16*)(F.ws + WS_WB);
    constexpr int I_A = (DM / 64) * (2 * DFF / 32), I_B = (DFF / 64) * (DM / 32);
    for (int it = gw; it < I_A + I_B; it += NGW) {
        int r = it;
        if (r < I_A) { const int nblk = 2 * DFF / 32, kb = r / nblk, nb = r % nblk, n0 = nb * 32;
            const int tile = n0 >> 8, within = n0 & 255; const bool up = within >= 128; const int sc = tile * 128 + (within & 127) + (lane & 31);
            const float* W = A.in[f ? (up ? I_F2U : I_F2G) : (up ? I_F1U : I_F1G)];
            transpose_item(W, DFF, DM, WA, n0, sc, kb * 64, scr, lane); continue; }
        r -= I_A;
        { const int nblk = DM / 32, kb = r / nblk, nb = r % nblk, n0 = nb * 32;
            transpose_item(A.in[f ? I_F2D : I_F1D], DM, DFF, WB, n0, n0 + (lane & 31), kb * 64, scr, lane); }
    }
}
__device__ __forceinline__ void p_prologue(Frame& F, const Args& A) {
    LAS float* scr = (LAS float*)(F.lds + F.wave * 16384);
    const int gw = F.bid * NWAVES + F.wave, NGW = F.G * NWAVES, lane = F.lane;
    bf16* WIN = (bf16*)(F.ws + WS_WIN); bf16* WQ = (bf16*)(F.ws + WS_WQ); bf16* WOUT = (bf16*)(F.ws + WS_WOUT);
    conv_ffn_weights(F, A, 0);
    constexpr int I_IN = (DM / 64) * (DINP / 32), I_Q = (256 / 64) * (768 / 32), I_O = (DM / 64) * (DM / 32);
    constexpr int NITEMS = I_IN + I_Q + I_O;
    for (int it = gw; it < NITEMS; it += NGW) {
        int r = it;
        if (r < I_IN) { const int nblk = DINP / 32, kb = r / nblk, nb = r % nblk, n0 = nb * 32;
            transpose_item(A.in[I_WIN], DIN, DM, WIN, n0, inproj_src(n0 + (lane & 31)), kb * 64, scr, lane); continue; }
        r -= I_IN;
        if (r < I_Q) { const int nblk = 768 / 32, kb = r / nblk, nb = r % nblk, n0 = nb * 32;
            if (n0 < 512) transpose_item(A.in[I_WQB], 512, 256, WQ, n0, n0 + (lane & 31), kb * 64, scr, lane);
            else transpose_item(A.in[I_WQIB], 256, 256, WQ, n0, n0 - 512 + (lane & 31), kb * 64, scr, lane);
            continue; }
        r -= I_Q;
        { const int nblk = DM / 32, kb = r / nblk, nb = r % nblk, n0 = nb * 32;
            transpose_item(A.in[I_WOUT], DM, DM, WOUT, n0, n0 + (lane & 31), kb * 64, scr, lane); }
    }
    bf16* XN = (bf16*)(F.ws + WS_XN);
    for (int m = gw; m < TT; m += NGW) rms_row_to_bf16(A.in[I_X] + (size_t)m * DM, A.in[I_F1PRE], XN + (size_t)m * DM, lane);
}

__device__ __forceinline__ void p_rowpass(Frame& F, const bf16* FB, const float* xin, const float* gpost, float scale, float* xout, const float* gnext, bf16* XN) {
    const int gw = F.bid * NWAVES + F.wave, NGW = F.G * NWAVES, lane = F.lane;
    for (int m = gw; m < TT; m += NGW) {
        const GAS v4u* fr = (const GAS v4u*)(FB + (size_t)m * DM) + lane;
        float f[16]; float s = 0.f;
#pragma unroll
        for (int j = 0; j < 2; ++j) { const v4u w = fr[64 * j];
            f[8 * j + 0] = bflo(w.x); f[8 * j + 1] = bfhi(w.x); f[8 * j + 2] = bflo(w.y); f[8 * j + 3] = bfhi(w.y); f[8 * j + 4] = bflo(w.z); f[8 * j + 5] = bfhi(w.z); f[8 * j + 6] = bflo(w.w); f[8 * j + 7] = bfhi(w.w); }
#pragma unroll
        for (int i = 0; i < 16; ++i) s += f[i] * f[i];
        const float rstd = 1.0f / sqrtf(wave_sum(s) * (1.f / DM) + NORM_EPS) * scale;
        float xn[16]; float s2 = 0.f;
#pragma unroll
        for (int j = 0; j < 2; ++j)
#pragma unroll
            for (int q = 0; q < 2; ++q) { const int c = 512 * j + 8 * lane + 4 * q; const f32x4 xi = *(const GAS f32x4*)(xin + (size_t)m * DM + c); const f32x4 gp = *(const GAS f32x4*)(gpost + c);
                f32x4 o;
#pragma unroll
                for (int i = 0; i < 4; ++i) { o[i] = xi[i] + f[8 * j + 4 * q + i] * rstd * gp[i]; xn[8 * j + 4 * q + i] = o[i]; s2 += o[i] * o[i]; }
                *(GAS f32x4*)(xout + (size_t)m * DM + c) = o; }
        if (gnext) {
            const float r2 = 1.0f / sqrtf(wave_sum(s2) * (1.f / DM) + NORM_EPS);
#pragma unroll
            for (int j = 0; j < 2; ++j) { const int c = 512 * j + 8 * lane; const f32x4 g0 = *(const GAS f32x4*)(gnext + c), g1 = *(const GAS f32x4*)(gnext + c + 4);
                v4u o; o.x = pk2(xn[8 * j + 0] * r2 * g0[0], xn[8 * j + 1] * r2 * g0[1]); o.y = pk2(xn[8 * j + 2] * r2 * g0[2], xn[8 * j + 3] * r2 * g0[3]);
                o.z = pk2(xn[8 * j + 4] * r2 * g1[0], xn[8 * j + 5] * r2 * g1[1]); o.w = pk2(xn[8 * j + 6] * r2 * g1[2], xn[8 * j + 7] * r2 * g1[3]);
                *(GAS v4u*)(XN + (size_t)m * DM + c) = o; }
        }
    }
}

__device__ __forceinline__ size_t fragA_idx(int unit, int i, int d) { const int rb = i >> 5, r = i & 31, ks = d >> 4, x = d & 15, c = x >> 3, h = (x >> 2) & 1, b = x & 3; return ((size_t)(unit * 2 + rb) * 8 + ks) * 512 + (h * 32 + r) * 8 + 4 * c + b; }
__device__ __forceinline__ size_t fragT_idx(int unit, int d, int j) { const int tc = d >> 5, r = d & 31, ks = j >> 4, y = j & 15, c = y >> 3, h = (y >> 2) & 1, b = y & 3; return ((size_t)(unit * 4 + tc) * 4 + ks) * 512 + (h * 32 + r) * 8 + 4 * c + b; }

__device__ __forceinline__ void p_prep1(Frame& F, const Args& A) {
    const int gw = F.bid * NWAVES + F.wave, NGW = F.G * NWAVES, lane = F.lane;
    bf16* CQ = (bf16*)(F.ws + WS_CQ); bf16* KATT = (bf16*)(F.ws + WS_KATT); const bf16* GRAW = (const bf16*)(F.ws + WS_GRAW); const float* SPEC = (const float*)(F.ws + WS_SPEC);
    __half* KIDX = (__half*)(F.ws + WS_KIDX); float* BETA = (float*)(F.ws + WS_BETA); float* GLOG = (float*)(F.ws + WS_GLOG); float* WIDX = (float*)(F.ws + WS_WIDX);
    bf16* QF = (bf16*)(F.ws + WS_QF); bf16* KF = (bf16*)(F.ws + WS_KF); bf16* KTF = (bf16*)(F.ws + WS_KTF); bf16* VTF = (bf16*)(F.ws + WS_VTF);
    const float* convw = A.in[I_CONV];
    for (int m = gw; m < TT; m += NGW) {
        const int t = m & (SEQ - 1); const float pos = (float)t;
        { GAS v2u* p = (GAS v2u*)(CQ + (size_t)m * 256) + lane; const v2u w = *p; const float a0 = bflo(w.x), a1 = bfhi(w.x), a2 = bflo(w.y), a3 = bfhi(w.y);
          const float rstd = 1.0f / sqrtf(wave_sum(a0 * a0 + a1 * a1 + a2 * a2 + a3 * a3) * (1.f / 256) + NORM_EPS); const f32x4 g = *(const GAS f32x4*)(A.in[I_QAG] + 4 * lane);
          v2u o; o.x = pk2(a0 * rstd * g[0], a1 * rstd * g[1]); o.y = pk2(a2 * rstd * g[2], a3 * rstd * g[3]); *p = o; }
        { const int hd = lane >> 3, d0 = (lane & 7) * 4; GAS v2u* p1 = (GAS v2u*)(KATT + (size_t)m * 512 + hd * 64 + d0); GAS v2u* p2 = (GAS v2u*)(KATT + (size_t)m * 512 + hd * 64 + d0 + 32);
          const v2u w1 = *p1, w2 = *p2; float x1[4] = {bflo(w1.x), bfhi(w1.x), bflo(w1.y), bfhi(w1.y)}, x2[4] = {bflo(w2.x), bfhi(w2.x), bflo(w2.y), bfhi(w2.y)}; float o1[4], o2[4];
#pragma unroll
          for (int i = 0; i < 4; ++i) { float c, s; rope_cs(pos, A.invf_att[d0 + i], c, s); o1[i] = x1[i] * c - x2[i] * s; o2[i] = x2[i] * c + x1[i] * s; }
          v2u a, b; a.x = pk2(o1[0], o1[1]); a.y = pk2(o1[2], o1[3]); b.x = pk2(o2[0], o2[1]); b.y = pk2(o2[2], o2[3]); *p1 = a; *p2 = b; }
        { const float v = SPEC[(size_t)m * 128 + lane]; const float mu = wave_sum(v) * (1.f / 64); const float xc = v - mu; const float var = wave_sum(xc * xc) * (1.f / 64);
          const float y = xc * (1.0f / sqrtf(var + NORM_EPS)) * A.in[I_KLG][lane] + A.in[I_KLB][lane];
          const float part = SWZ_XOR(y, 16); float c, s; rope_cs(pos, A.invf_idx[lane & 15], c, s);
          float o = y; if (lane < 16) o = y * c - part * s; else if (lane < 32) o = y * c + part * s;
          KIDX[(size_t)m * 64 + lane] = __float2half(o); }
        if (lane < 4) { const float gb = SPEC[(size_t)m * 128 + 68 + lane], ga = SPEC[(size_t)m * 128 + 72 + lane];
          BETA[(size_t)m * 4 + lane] = sigmoid_f(gb);
          const float xx = ga + A.in[I_DTB][lane]; const float sp = fmaxf(xx, 0.f) + log1pf(__expf(-fabsf(xx)));
          GLOG[(size_t)m * 4 + lane] = -__expf(A.in[I_ALOG][lane]) * sp;
          WIDX[(size_t)m * 4 + lane] = SPEC[(size_t)m * 128 + 64 + lane]; }
    }
    for (int blk = gw; blk < TT / 8; blk += NGW) {
        const int b = blk >> 10, n = (blk & 1023) >> 3, a = blk & 7; const int t0 = 64 * n + 8 * a; const size_t m0 = (size_t)b * SEQ + t0;
        const int gsub = lane >> 4, ks = (lane & 15) >> 1, hh = lane & 1; const int ch0 = 16 * ks + 4 * hh;
#pragma unroll 1
        for (int pass = 0; pass < 3; ++pass) {
            const int cbase = pass * 512 + gsub * 128 + ch0; const int unit = (b * 4 + gsub) * 128 + n;
            float wc[4][8];
#pragma unroll
            for (int jj = 0; jj < 4; ++jj) { const f32x4 w0 = *(const GAS f32x4*)(convw + jj * 1536 + cbase), w1 = *(const GAS f32x4*)(convw + jj * 1536 + cbase + 8);
#pragma unroll
                for (int e = 0; e < 4; ++e) { wc[jj][e] = w0[e]; wc[jj][4 + e] = w1[e]; } }
            float y[8][8];
#pragma unroll
            for (int tk = 0; tk < 8; ++tk)
#pragma unroll
                for (int e = 0; e < 8; ++e) y[tk][e] = 0.f;
#pragma unroll
            for (int rr = 0; rr < 11; ++rr) { float x[8];
                if (t0 - 3 + rr >= 0) { const v2u w0 = *(const GAS v2u*)(GRAW + (m0 - 3 + rr) * 1536 + cbase), w1 = *(const GAS v2u*)(GRAW + (m0 - 3 + rr) * 1536 + cbase + 8);
                    x[0] = bflo(w0.x); x[1] = bfhi(w0.x); x[2] = bflo(w0.y); x[3] = bfhi(w0.y); x[4] = bflo(w1.x); x[5] = bfhi(w1.x); x[6] = bflo(w1.y); x[7] = bfhi(w1.y); }
                else {
#pragma unroll
                    for (int e = 0; e < 8; ++e) x[e] = 0.f; }
#pragma unroll
                for (int jj = 0; jj < 4; ++jj) { const int tk = rr - jj; if (tk >= 0 && tk < 8) {
#pragma unroll
                    for (int e = 0; e < 8; ++e) y[tk][e] += wc[jj][e] * x[e]; } } }
#pragma unroll
            for (int tk = 0; tk < 8; ++tk) { float ss = 0.f;
#pragma unroll
                for (int e = 0; e < 8; ++e) { y[tk][e] = silu2(y[tk][e]); ss += y[tk][e] * y[tk][e]; }
                if (pass < 2) { ss += SWZ_XOR(ss, 1); ss += SWZ_XOR(ss, 2); ss += SWZ_XOR(ss, 4); ss += SWZ_XOR(ss, 8); const float r = 1.0f / sqrtf(ss + NORM_EPS);
#pragma unroll
                    for (int e = 0; e < 8; ++e) y[tk][e] *= r; } }
            if (pass < 2) { bf16* dst = pass == 0 ? QF : KF;
#pragma unroll
                for (int tk = 0; tk < 8; ++tk) { const int i = 8 * a + tk; v4u o; o.x = pk2(y[tk][0], y[tk][1]); o.y = pk2(y[tk][2], y[tk][3]); o.z = pk2(y[tk][4], y[tk][5]); o.w = pk2(y[tk][6], y[tk][7]);
                    *(GAS v4u*)(dst + ((size_t)(unit * 2 + (i >> 5)) * 8 + ks) * 512 + (hh * 32 + (i & 31)) * 8) = o; } }
            if (pass >= 1) { bf16* dst = pass == 1 ? KTF : VTF;
#pragma unroll
                for (int e = 0; e < 8; ++e) { const int d = ch0 + (e & 3) + 8 * (e >> 2); const size_t base = ((size_t)(unit * 4 + (d >> 5)) * 4 + (a >> 1)) * 512 + (d & 31) * 8 + 4 * (a & 1);
                    v2u o0, o1; o0.x = pk2(y[0][e], y[1][e]); o0.y = pk2(y[2][e], y[3][e]); o1.x = pk2(y[4][e], y[5][e]); o1.y = pk2(y[6][e], y[7][e]);
                    *(GAS v2u*)(dst + base) = o0; *(GAS v2u*)(dst + base + 32 * 8) = o1; } }
        }
    }
}
__device__ __forceinline__ void p_prep2(Frame& F, const Args& A, int gw, int NGW) {
    const int lane = F.lane;
    const bf16* QRAW = (const bf16*)(F.ws + WS_QRAW); bf16* Q = (bf16*)(F.ws + WS_Q); __half* QIDX = (__half*)(F.ws + WS_QIDX);
    for (int m = gw; m < TT; m += NGW) {
        const int t = m & (SEQ - 1); const float pos = (float)t;
        { const int hd = lane >> 3, d0 = (lane & 7) * 4; const v2u w1 = *(const GAS v2u*)(QRAW + (size_t)m * 768 + hd * 64 + d0), w2 = *(const GAS v2u*)(QRAW + (size_t)m * 768 + hd * 64 + d0 + 32);
          float x1[4] = {bflo(w1.x), bfhi(w1.x), bflo(w1.y), bfhi(w1.y)}, x2[4] = {bflo(w2.x), bfhi(w2.x), bflo(w2.y), bfhi(w2.y)}; float o1[4], o2[4];
#pragma unroll
          for (int i = 0; i < 4; ++i) { float c, s; rope_cs(pos, A.invf_att[d0 + i], c, s); o1[i] = (x1[i] * c - x2[i] * s) * C2; o2[i] = (x2[i] * c + x1[i] * s) * C2; }
          v2u a, b; a.x = pk2(o1[0], o1[1]); a.y = pk2(o1[2], o1[3]); b.x = pk2(o2[0], o2[1]); b.y = pk2(o2[2], o2[3]);
          *(GAS v2u*)(Q + (size_t)m * 512 + hd * 64 + d0) = a; *(GAS v2u*)(Q + (size_t)m * 512 + hd * 64 + d0 + 32) = b; }
        { const int hd = lane >> 4, i = lane & 15; const bf16* src = QRAW + (size_t)m * 768 + 512 + hd * 64; __half* dst = QIDX + (size_t)m * 256 + hd * 64;
          const float x1 = bf2f(src[i]), x2 = bf2f(src[i + 16]); float c, s; rope_cs(pos, A.invf_idx[i], c, s);
          dst[i] = __float2half(x1 * c - x2 * s); dst[i + 16] = __float2half(x2 * c + x1 * s);
          dst[32 + 2 * i] = __float2half(bf2f(src[32 + 2 * i])); dst[33 + 2 * i] = __float2half(bf2f(src[33 + 2 * i])); }
    }
}

__device__ __forceinline__ unsigned sortable(float x) { const unsigned u = __builtin_bit_cast(unsigned, x); return (u & 0x80000000u) ? ~u : (u | 0x80000000u); }
__device__ __forceinline__ void p_dsa_naive(Frame& F, const Args& A, int first_blk, int nblk) {
    const int tid = F.tid, lane = F.lane, wave = F.wave;
    const bf16* Q = (const bf16*)(F.ws + WS_Q); const bf16* KATT = (const bf16*)(F.ws + WS_KATT); const bf16* VATT = (const bf16*)(F.ws + WS_VATT);
    const __half* QIDX = (const __half*)(F.ws + WS_QIDX); const __half* KIDX = (const __half*)(F.ws + WS_KIDX); const float* WIDX = (const float*)(F.ws + WS_WIDX);
    unsigned long long* MASK = (unsigned long long*)(F.ws + WS_MASK); bf16* CAT = (bf16*)(F.ws + WS_CAT);
    LAS float* qi = (LAS float*)(F.lds);
    LAS float* wv = (LAS float*)(F.lds + 1024);
    LAS int* cntb = (LAS int*)(F.lds + 1280);
    LAS unsigned long long* mw = (LAS unsigned long long*)(F.lds + 2048);
    LAS int* pref = (LAS int*)(F.lds + 4096);
    LAS int* sel = (LAS int*)(F.lds + 8192);
    LAS float* P = (LAS float*)(F.lds + 16384);
    int par = 0;
    for (int m = F.bid - first_blk; m < TT; m += nblk) {
        const int b = m >> 13, t = m & (SEQ - 1);
        __syncthreads();
        if (tid < 256) qi[tid] = __half2float(QIDX[(size_t)m * 256 + tid]);
        if (tid < 4) wv[tid] = WIDX[(size_t)m * 4 + tid];
        __syncthreads();
        unsigned key[16];
#pragma unroll
        for (int j = 0; j < 16; ++j) { const int s = tid + 512 * j; key[j] = 0u;
            if (s <= t) { const v4u* kp = (const v4u*)(KIDX + ((size_t)b * SEQ + s) * 64); float d0 = 0.f, d1 = 0.f, d2 = 0.f, d3 = 0.f;
#pragma unroll
                for (int c = 0; c < 8; ++c) { const v4u w = kp[c]; const unsigned ww[4] = {w.x, w.y, w.z, w.w};
#pragma unroll
                    for (int e = 0; e < 4; ++e) { const __half2 h2 = __builtin_bit_cast(__half2, ww[e]); const float k0 = __low2float(h2), k1 = __high2float(h2); const int d = c * 8 + e * 2;
                        d0 += qi[d] * k0 + qi[d + 1] * k1; d1 += qi[64 + d] * k0 + qi[64 + d + 1] * k1; d2 += qi[128 + d] * k0 + qi[128 + d + 1] * k1; d3 += qi[192 + d] * k0 + qi[192 + d + 1] * k1; } }
                const float sc = wv[0] * fmaxf(d0, 0.f) + wv[1] * fmaxf(d1, 0.f) + wv[2] * fmaxf(d2, 0.f) + wv[3] * fmaxf(d3, 0.f);
                key[j] = sortable(sc); } }
#define BCOUNT(PRED, OUT) do { int c_ = 0; _Pragma("unroll") for (int j = 0; j < 16; ++j) { const int s = tid + 512 * j; (void)s; c_ += (int)__popcll(__ballot(PRED)); } \
            if (lane == 0) cntb[par * 8 + wave] = c_; __syncthreads(); int t_ = 0; _Pragma("unroll") for (int w_ = 0; w_ < 8; ++w_) t_ += cntb[par * 8 + w_]; par ^= 1; OUT = t_; } while (0)
        unsigned vstar = 1u; int cutoff = SEQ;
        if (t + 1 > TOPK) {
            unsigned cur = 0u;
            for (int bit = 31; bit >= 0; --bit) { const unsigned v = cur | (1u << bit); int c; BCOUNT(key[j] >= v, c); if (c >= TOPK) cur = v; }
            vstar = cur; int cgt; BCOUNT(key[j] > vstar, cgt); const int need = TOPK - cgt;
            int lo = 0, hi = SEQ - 1;
            while (lo < hi) { const int mid = (lo + hi) >> 1; int c; BCOUNT(key[j] == vstar && s <= mid, c); if (c >= need) hi = mid; else lo = mid + 1; }
            cutoff = lo;
        }
        bool selj[16];
#pragma unroll
        for (int j = 0; j < 16; ++j) { const int s = tid + 512 * j; selj[j] = (t + 1 > TOPK) ? (key[j] > vstar || (key[j] == vstar && s <= cutoff)) : (s <= t);
            const unsigned long long bm = __ballot(selj[j]); if (lane == 0) { mw[8 * j + wave] = bm; MASK[(size_t)m * 128 + 8 * j + wave] = bm; } }
        __syncthreads();
        if (wave == 0) { int c0 = (int)__popcll(mw[2 * lane]), c1 = (int)__popcll(mw[2 * lane + 1]); int s = c0 + c1, inc = s;
#pragma unroll
            for (int o = 1; o < 64; o <<= 1) { const int u = __shfl_up(inc, o); if (lane >= o) inc += u; }
            const int ex = inc - s; pref[2 * lane] = ex; pref[2 * lane + 1] = ex + c0; }
        __syncthreads();
#pragma unroll
        for (int j = 0; j < 16; ++j) if (selj[j]) { const int wd = 8 * j + wave; const int pos = pref[wd] + (int)__popcll(mw[wd] & ((1ull << lane) - 1ull)); if (pos < TOPK) sel[pos] = tid + 512 * j; }
        __syncthreads();
        const int nsel = (t + 1 < TOPK) ? t + 1 : TOPK;
        { const int h = wave; float qv[64];
          { const v4u* qp = (const v4u*)(Q + (size_t)m * 512 + h * 64);
#pragma unroll
            for (int c = 0; c < 8; ++c) { const v4u w = qp[c]; qv[8 * c] = bflo(w.x); qv[8 * c + 1] = bfhi(w.x); qv[8 * c + 2] = bflo(w.y); qv[8 * c + 3] = bfhi(w.y); qv[8 * c + 4] = bflo(w.z); qv[8 * c + 5] = bfhi(w.z); qv[8 * c + 6] = bflo(w.w); qv[8 * c + 7] = bfhi(w.w); } }
          float lg[4];
#pragma unroll
          for (int kk = 0; kk < 4; ++kk) { const int idx = lane + 64 * kk; lg[kk] = -INFINITY;
            if (idx < nsel) { const int s = sel[idx]; const v4u* kp = (const v4u*)(KATT + ((size_t)b * SEQ + s) * 512 + h * 64); float d = 0.f;
#pragma unroll
                for (int c = 0; c < 8; ++c) { const v4u w = kp[c]; d += qv[8 * c] * bflo(w.x) + qv[8 * c + 1] * bfhi(w.x) + qv[8 * c + 2] * bflo(w.y) + qv[8 * c + 3] * bfhi(w.y) + qv[8 * c + 4] * bflo(w.z) + qv[8 * c + 5] * bfhi(w.z) + qv[8 * c + 6] * bflo(w.w) + qv[8 * c + 7] * bfhi(w.w); }
                lg[kk] = d; } }
          const float mx = wave_max(fmaxf(fmaxf(lg[0], lg[1]), fmaxf(lg[2], lg[3]))); float ps = 0.f;
#pragma unroll
          for (int kk = 0; kk < 4; ++kk) { const float p = __builtin_amdgcn_exp2f(lg[kk] - mx); ps += p; P[h * 256 + lane + 64 * kk] = p; }
          const float tot = wave_sum(ps);
          LDS_WAIT(); asm volatile("" ::: "memory");
          float acc = 0.f;
          for (int idx = 0; idx < nsel; ++idx) { const int s = sel[idx]; acc += P[h * 256 + idx] * bf2f(VATT[((size_t)b * SEQ + s) * 512 + h * 64 + lane]); }
          CAT[(size_t)m * 1024 + h * 64 + lane] = (bf16)f2bf(acc / tot); }
    }
#undef BCOUNT
}

__device__ __forceinline__ void p_gdn_naive(Frame& F, const Args& A, int bh) {
    const int tid = F.tid, lane = F.lane, wave = F.wave; const int b = bh >> 2, h = bh & 3; const int e = tid & 127, ds = tid >> 7;
    const bf16* QF = (const bf16*)(F.ws + WS_QF); const bf16* KF = (const bf16*)(F.ws + WS_KF); const bf16* VTF = (const bf16*)(F.ws + WS_VTF); const bf16* GZ = (const bf16*)(F.ws + WS_GZ);
    const float* BETA = (const float*)(F.ws + WS_BETA); const float* GLOG = (const float*)(F.ws + WS_GLOG); bf16* CAT = (bf16*)(F.ws + WS_CAT);
    LAS float* red1 = (LAS float*)(F.lds + 65536); LAS float* red2 = (LAS float*)(F.lds + 65536 + 2048); LAS float* small = (LAS float*)(F.lds + 65536 + 4096);
    float S[32];
#pragma unroll
    for (int i = 0; i < 32; ++i) S[i] = 0.f;
    const float gout = A.in[I_GOUTG][e];
    for (int t = 0; t < SEQ; ++t) {
        const size_t row = (size_t)b * SEQ + t; const int unit = bh * 128 + (t >> 6), i = t & 63;
        float kk[32], qq[32];
#pragma unroll
        for (int c = 0; c < 32; ++c) { kk[c] = bf2f(KF[fragA_idx(unit, i, ds * 32 + c)]); qq[c] = bf2f(QF[fragA_idx(unit, i, ds * 32 + c)]); }
        const float v = bf2f(VTF[fragT_idx(unit, e, i)]); const float beta = BETA[row * 4 + h]; const float a = __expf(GLOG[row * 4 + h]);
        float part = 0.f;
#pragma unroll
        for (int c = 0; c < 32; ++c) part += kk[c] * S[c];
        red1[ds * 128 + e] = part; __syncthreads();
        const float kS = (red1[e] + red1[128 + e]) + (red1[256 + e] + red1[384 + e]);
        const float vn = beta * (v - a * kS);
        float po = 0.f;
#pragma unroll
        for (int c = 0; c < 32; ++c) { S[c] = a * S[c] + kk[c] * vn; po += qq[c] * S[c]; }
        red2[ds * 128 + e] = po; __syncthreads();
        float o = 0.f;
        if (ds == 0) { o = ((red2[e] + red2[128 + e]) + (red2[256 + e] + red2[384 + e])) * 0.08838834764831845f; const float ss = wave_sum(o * o); if (lane == 0) small[wave] = ss; }
        __syncthreads();
        if (ds == 0) { const float rstd = 1.0f / sqrtf((small[0] + small[1]) * (1.f / 128) + NORM_EPS); const float z = bf2f(GZ[row * 512 + h * 128 + e]);
            CAT[row * 1024 + 512 + h * 128 + e] = (bf16)f2bf(o * rstd * gout * silu2(z)); }
    }
}

typedef short bf16x8 __attribute__((ext_vector_type(8)));
typedef float f32x16 __attribute__((ext_vector_type(16)));
typedef float f32x2_t __attribute__((ext_vector_type(2))); typedef __bf16 bf16x2_t __attribute__((ext_vector_type(2)));
__device__ __forceinline__ unsigned cvtpk(float lo, float hi) { f32x2_t v = {lo, hi}; bf16x2_t b = __builtin_convertvector(v, bf16x2_t); return __builtin_bit_cast(unsigned, b); }
#define PACK8(A_, B_) __builtin_bit_cast(bf16x8, (v4u){cvtpk((A_)[(B_)], (A_)[(B_) + 1]), cvtpk((A_)[(B_) + 2], (A_)[(B_) + 3]), cvtpk((A_)[(B_) + 4], (A_)[(B_) + 5]), cvtpk((A_)[(B_) + 6], (A_)[(B_) + 7])})
#define MFMA32(a_, b_, c_) __builtin_amdgcn_mfma_f32_32x32x16_bf16((a_), (b_), (c_), 0, 0, 0)
constexpr int GF_STRIDE = 192;
constexpr float GDN_SCALE = 0.08838834764831845f;
__device__ __forceinline__ void gdn_pre_unit(Frame& F, int unit, LAS unsigned char* wl) {
    int lane = F.lane; asm volatile("" : "+v"(lane));
    const int c = lane & 31, half = lane >> 5;
    const int bh = unit >> 7, n = unit & 127, b = bh >> 2, h = bh & 3; const size_t m0 = (size_t)b * SEQ + 64 * n;
    const bf16* QF = (const bf16*)(F.ws + WS_QF); const bf16* KF = (const bf16*)(F.ws + WS_KF); const bf16* KTF = (const bf16*)(F.ws + WS_KTF); const bf16* VTF = (const bf16*)(F.ws + WS_VTF);
    const float* BETA = (const float*)(F.ws + WS_BETA); const float* GLOG = (const float*)(F.ws + WS_GLOG);
    bf16* WF = (bf16*)(F.ws + WS_WF); bf16* UC = (bf16*)(F.ws + WS_UC); bf16* QKF = (bf16*)(F.ws + WS_QKF); float* GF = (float*)(F.ws + WS_GF);
    { unsigned wb_ = (unsigned)(uintptr_t)wl; asm volatile("" : "+v"(wb_)); wl = (LAS unsigned char*)(uintptr_t)wb_; }
    LAS float* AT = (LAS float*)wl; LAS float* Tl = (LAS float*)(wl + 16384); LAS float* gcl = (LAS float*)(wl + 32768); LAS float* btl = gcl + 64; LAS float* bgl = gcl + 128;
    const float gl = GLOG[(m0 + lane) * 4 + h], bt = BETA[(m0 + lane) * 4 + h];
    float gc = gl;
#pragma unroll
    for (int o = 1; o < 64; o <<= 1) { const float u = __builtin_bit_cast(float, __builtin_amdgcn_ds_bpermute((lane - o) << 2, __builtin_bit_cast(int, gc))); if (lane >= o) gc += u; }
    const float gc63 = __builtin_bit_cast(float, __builtin_amdgcn_readlane(__builtin_bit_cast(int, gc), 63));
    gcl[lane] = gc; btl[lane] = bt; bgl[lane] = bt * __expf(gc);
    GF[(size_t)unit * GF_STRIDE + lane] = __expf(gc) * GDN_SCALE; GF[(size_t)unit * GF_STRIDE + 64 + lane] = __expf(gc63 - gc); if (lane == 0) GF[(size_t)unit * GF_STRIDE + 128] = __expf(gc63);
    bf16x8 kf[2][8];
#pragma unroll
    for (int rb = 0; rb < 2; ++rb)
#pragma unroll
        for (int ks = 0; ks < 8; ++ks) kf[rb][ks] = *(const GAS bf16x8*)(KF + ((size_t)(unit * 2 + rb) * 8 + ks) * 512 + lane * 8);
    LDS_WAIT(); asm volatile("" ::: "memory");
#pragma unroll
    for (int tile = 0; tile < 3; ++tile) { const int tr = tile >= 1, tc = tile >= 2; f32x16 acc = {};
#pragma unroll
        for (int ks = 0; ks < 8; ++ks) acc = MFMA32(kf[tr][ks], kf[tc][ks], acc);
        const int C = 32 * tc + c; const float gcC = gcl[C];
#pragma unroll
        for (int reg = 0; reg < 16; ++reg) { const int R = 32 * tr + (reg & 3) + 8 * (reg >> 2) + 4 * half; AT[C * 64 + R] = btl[R] * acc[reg] * __expf(gcl[R] - gcC); } }
#pragma unroll
    for (int tile = 0; tile < 3; ++tile) { const int tj = tile >= 2, ti = tile >= 1; f32x16 acc = {};
#pragma unroll
        for (int ks = 0; ks < 8; ++ks) acc = MFMA32(kf[tj][ks], *(const GAS bf16x8*)(QF + ((size_t)(unit * 2 + ti) * 8 + ks) * 512 + lane * 8), acc);
        asm volatile("" ::: "memory");
        const int I = 32 * ti + c; const float gcI = gcl[I]; float v[16];
#pragma unroll
        for (int reg = 0; reg < 16; ++reg) { const int J = 32 * tj + (reg & 3) + 8 * (reg >> 2) + 4 * half; v[reg] = (J <= I) ? acc[reg] * __expf(gcI - gcl[J]) * GDN_SCALE : 0.f; }
        *(GAS bf16x8*)(QKF + ((size_t)(unit * 2 + ti) * 4 + 2 * tj) * 512 + lane * 8) = PACK8(v, 0);
        *(GAS bf16x8*)(QKF + ((size_t)(unit * 2 + ti) * 4 + 2 * tj + 1) * 512 + lane * 8) = PACK8(v, 8); }
    LDS_WAIT(); asm volatile("" ::: "memory");
    Tl[63 * 64 + lane] = (lane == 63) ? 1.f : 0.f;
#pragma unroll 1
    for (int j = 62; j >= 0; --j) { float acc = (lane == j) ? 1.f : 0.f;
#pragma unroll 4
        for (int k = j + 1; k < 64; ++k) acc -= Tl[k * 64 + lane] * AT[j * 64 + k];
        Tl[j * 64 + lane] = acc; }
    LDS_WAIT(); asm volatile("" ::: "memory");
    LAS unsigned char* TbF = wl; LAS unsigned char* TbgF = wl + 8192;
    { const int rb = lane >> 5, r = lane & 31;
#pragma unroll 1
      for (int ks = 0; ks < 4; ++ks)
#pragma unroll
        for (int hh = 0; hh < 2; ++hh) { float x[8], y[8];
#pragma unroll
            for (int jj = 0; jj < 8; ++jj) { const int jt = 16 * ks + 8 * (jj >> 2) + 4 * hh + (jj & 3); const float tv = Tl[jt * 64 + lane]; x[jj] = tv * btl[jt]; y[jj] = tv * bgl[jt]; }
            *(LAS bf16x8*)(TbF + ((rb * 4 + ks) * 64 + hh * 32 + r) * 16) = PACK8(x, 0); *(LAS bf16x8*)(TbgF + ((rb * 4 + ks) * 64 + hh * 32 + r) * 16) = PACK8(y, 0); } }
    LDS_WAIT(); asm volatile("" ::: "memory");
#pragma unroll 1
    for (int rb = 0; rb < 2; ++rb)
#pragma unroll 1
        for (int cb = 0; cb < 4; ++cb) { f32x16 acc = {};
#pragma unroll
            for (int ks = 0; ks < 4; ++ks) acc = MFMA32(*(const LAS bf16x8*)(TbF + ((rb * 4 + ks) * 64 + lane) * 16), *(const GAS bf16x8*)(VTF + ((size_t)(unit * 4 + cb) * 4 + ks) * 512 + lane * 8), acc);
            bf16* dst = UC + (((size_t)(unit * 2 + rb) * 128 + 32 * cb + c) * 2 + half) * 16;
            *(GAS bf16x8*)dst = PACK8(acc, 0); *(GAS bf16x8*)(dst + 8) = PACK8(acc, 8); }
#pragma unroll 1
    for (int tdk = 0; tdk < 4; ++tdk)
#pragma unroll 1
        for (int rb = 0; rb < 2; ++rb) { f32x16 acc = {};
#pragma unroll
            for (int ks = 0; ks < 4; ++ks) acc = MFMA32(*(const GAS bf16x8*)(KTF + ((size_t)(unit * 4 + tdk) * 4 + ks) * 512 + lane * 8), *(const LAS bf16x8*)(TbgF + ((rb * 4 + ks) * 64 + lane) * 16), acc);
            *(GAS bf16x8*)(WF + ((size_t)(unit * 2 + rb) * 8 + 2 * tdk) * 512 + lane * 8) = PACK8(acc, 0);
            *(GAS bf16x8*)(WF + ((size_t)(unit * 2 + rb) * 8 + 2 * tdk + 1) * 512 + lane * 8) = PACK8(acc, 8); }
    LDS_WAIT(); asm volatile("" ::: "memory");
}

constexpr int SC_BUF = 57344, SC_W = 0, SC_Q = 16384, SC_KT = 32768, SC_QK = 49152, SC_OST = 2 * SC_BUF, OST_LD = 132, SC_GF = SC_OST + 64 * OST_LD * 4, SC_END = SC_GF + 2 * GF_STRIDE * 4;
__device__ __forceinline__ void p_gdn_scan(Frame& F, const Args& A, int bh) {
    const int lane = F.lane, wave = F.wave, c = lane & 31, half = lane >> 5; const int b = bh >> 2, h = bh & 3;
    const bf16* QF = (const bf16*)(F.ws + WS_QF); const bf16* KTF = (const bf16*)(F.ws + WS_KTF); const bf16* WF = (const bf16*)(F.ws + WS_WF); const bf16* UC = (const bf16*)(F.ws + WS_UC); const bf16* QKF = (const bf16*)(F.ws + WS_QKF);
    const float* GF = (const float*)(F.ws + WS_GF); const bf16* GZ = (const bf16*)(F.ws + WS_GZ); bf16* CAT = (bf16*)(F.ws + WS_CAT);
    LAS unsigned char* lds = F.lds; LAS float* Ost = (LAS float*)(lds + SC_OST);
    if (wave >= 4) {
        const int lw = wave - 4; v4u st[14]; v4u sg = {0u, 0u, 0u, 0u};
        const int etok = 16 * lw + (lane >> 2), edv = (lane & 3) * 32;
        float go[32];
#pragma unroll
        for (int i = 0; i < 32; ++i) go[i] = A.in[I_GOUTG][edv + i];
#define SC_LOAD(n_) do { const int un_ = bh * 128 + (n_); _Pragma("unroll") for (int i_ = 0; i_ < 14; ++i_) { const int p_ = lw * 64 + lane + 256 * i_; \
            const bf16* s_ = i_ < 4 ? WF + (size_t)un_ * 8192 + (size_t)p_ * 8 : i_ < 8 ? QF + (size_t)un_ * 8192 + (size_t)(p_ - 1024) * 8 : i_ < 12 ? KTF + (size_t)un_ * 8192 + (size_t)(p_ - 2048) * 8 : QKF + (size_t)un_ * 4096 + (size_t)(p_ - 3072) * 8; \
            st[i_] = *(const GAS v4u*)s_; } if (lw == 0 && lane < 48) sg = *(const GAS v4u*)(GF + (size_t)un_ * GF_STRIDE + lane * 4); } while (0)
#define SC_STORE(n_) do { LAS unsigned char* d_ = lds + ((n_) & 1) * SC_BUF; _Pragma("unroll") for (int i_ = 0; i_ < 14; ++i_) *(LAS v4u*)(d_ + (lw * 64 + lane + 256 * i_) * 16) = st[i_]; \
            if (lw == 0 && lane < 48) *(LAS v4u*)(lds + SC_GF + ((n_) & 1) * GF_STRIDE * 4 + lane * 16) = sg; } while (0)
        SC_LOAD(0); SC_STORE(0); LDS_WAIT();
        __syncthreads();
        SC_LOAD(1);
        for (int n = 0; n < 128; ++n) {
            const size_t row = (size_t)b * SEQ + 64 * n + etok;
            v4u zz[4];
#pragma unroll
            for (int i = 0; i < 4; ++i) zz[i] = *(const GAS v4u*)(GZ + row * 512 + h * 128 + edv + 8 * i);
            __syncthreads();
            if (n + 1 < 128) SC_STORE(n + 1);
            LDS_WAIT();
            __syncthreads();
            if (n + 2 < 128) SC_LOAD(n + 2);
            float o[32]; float ss = 0.f;
#pragma unroll
            for (int i = 0; i < 8; ++i) { const f32x4 v = *(const LAS f32x4*)(Ost + etok * OST_LD + edv + 4 * i); o[4 * i] = v[0]; o[4 * i + 1] = v[1]; o[4 * i + 2] = v[2]; o[4 * i + 3] = v[3]; ss += (v[0] * v[0] + v[1] * v[1]) + (v[2] * v[2] + v[3] * v[3]); }
            ss += SWZ_XOR(ss, 1); ss += SWZ_XOR(ss, 2);
            const float rstd = 1.0f / sqrtf(ss * (1.f / 128) + NORM_EPS);
#pragma unroll
            for (int i = 0; i < 4; ++i) { const unsigned zw[4] = {zz[i].x, zz[i].y, zz[i].z, zz[i].w}; v4u ov; unsigned ow[4];
#pragma unroll
                for (int e = 0; e < 4; ++e) { const float z0 = bflo(zw[e]), z1 = bfhi(zw[e]); const int k = 8 * i + 2 * e; ow[e] = pk2(o[k] * rstd * go[k] * silu2(z0), o[k + 1] * rstd * go[k + 1] * silu2(z1)); }
                ov.x = ow[0]; ov.y = ow[1]; ov.z = ow[2]; ov.w = ow[3];
                *(GAS v4u*)(CAT + row * 1024 + 512 + h * 128 + edv + 8 * i) = ov; }
        }
#undef SC_LOAD
#undef SC_STORE
    } else {
        const int dv = 32 * wave + c;
        f32x16 S[4];
#pragma unroll
        for (int t = 0; t < 4; ++t) S[t] = (f32x16){};
        v4u ur[2][2];
#define SC_ULOAD(n_) do { const bf16* up_ = UC + (((size_t)((bh * 128 + (n_)) * 2) * 128 + dv) * 2 + half) * 16; _Pragma("unroll") for (int rb_ = 0; rb_ < 2; ++rb_) { ur[rb_][0] = *(const GAS v4u*)(up_ + (size_t)rb_ * 128 * 32); ur[rb_][1] = *(const GAS v4u*)(up_ + (size_t)rb_ * 128 * 32 + 8); } } while (0)
        SC_ULOAD(0);
        __syncthreads();
        for (int n = 0; n < 128; ++n) {
            const LAS unsigned char* buf = lds + (n & 1) * SC_BUF; const LAS float* gf = (const LAS float*)(lds + SC_GF + (n & 1) * GF_STRIDE * 4);
            bf16x8 Sb[8];
#pragma unroll
            for (int t = 0; t < 4; ++t) { Sb[2 * t] = PACK8(S[t], 0); Sb[2 * t + 1] = PACK8(S[t], 8); }
            f32x16 o[2], P[2];
#pragma unroll
            for (int rb = 0; rb < 2; ++rb) { o[rb] = (f32x16){}; P[rb] = (f32x16){};
#pragma unroll
                for (int ks = 0; ks < 8; ++ks) { P[rb] = MFMA32(*(const LAS bf16x8*)(buf + SC_W + ((rb * 8 + ks) * 64 + lane) * 16), Sb[ks], P[rb]); o[rb] = MFMA32(*(const LAS bf16x8*)(buf + SC_Q + ((rb * 8 + ks) * 64 + lane) * 16), Sb[ks], o[rb]); } }
            bf16x8 VNb[4], VNd[4];
#pragma unroll
            for (int rb = 0; rb < 2; ++rb) { const unsigned uw[8] = {ur[rb][0].x, ur[rb][0].y, ur[rb][0].z, ur[rb][0].w, ur[rb][1].x, ur[rb][1].y, ur[rb][1].z, ur[rb][1].w}; float vn[16], vd[16];
#pragma unroll
                for (int a = 0; a < 4; ++a) { const f32x4 eg = *(const LAS f32x4*)(gf + 32 * rb + 8 * a + 4 * half), dd = *(const LAS f32x4*)(gf + 64 + 32 * rb + 8 * a + 4 * half);
#pragma unroll
                    for (int e = 0; e < 4; ++e) { const int reg = 4 * a + e; const float u = (reg & 1) ? bfhi(uw[reg >> 1]) : bflo(uw[reg >> 1]); vn[reg] = u - P[rb][reg]; vd[reg] = vn[reg] * dd[e]; o[rb][reg] *= eg[e]; } }
                VNb[2 * rb] = PACK8(vn, 0); VNb[2 * rb + 1] = PACK8(vn, 8); VNd[2 * rb] = PACK8(vd, 0); VNd[2 * rb + 1] = PACK8(vd, 8); }
            if (n + 1 < 128) SC_ULOAD(n + 1);
#pragma unroll
            for (int ks = 0; ks < 2; ++ks) o[0] = MFMA32(*(const LAS bf16x8*)(buf + SC_QK + ((0 * 4 + ks) * 64 + lane) * 16), VNb[ks], o[0]);
#pragma unroll
            for (int ks = 0; ks < 4; ++ks) o[1] = MFMA32(*(const LAS bf16x8*)(buf + SC_QK + ((1 * 4 + ks) * 64 + lane) * 16), VNb[ks], o[1]);
            __syncthreads();
#pragma unroll
            for (int rb = 0; rb < 2; ++rb)
#pragma unroll
                for (int reg = 0; reg < 16; ++reg) Ost[(32 * rb + (reg & 3) + 8 * (reg >> 2) + 4 * half) * OST_LD + dv] = o[rb][reg];
            const float gam = gf[128];
            LDS_WAIT();
#pragma unroll
            for (int t = 0; t < 4; ++t) { S[t] *= gam;
#pragma unroll
                for (int ks = 0; ks < 4; ++ks) S[t] = MFMA32(*(const LAS bf16x8*)(buf + SC_KT + ((t * 4 + ks) * 64 + lane) * 16), VNd[ks], S[t]); }
            __syncthreads();
        }
#undef SC_ULOAD
    }
}

#ifndef XMASK
#define XMASK 0
#endif
enum { PH_PRO = 0, PH_F1A, PH_F1B, PH_ROW1, PH_INPROJ, PH_PREP1, PH_QPROJ, PH_PREP2, PH_MIX, PH_OUTPROJ, PH_ROW2, PH_F2A, PH_F2B, PH_ROW3, PH_N };

__global__ void __launch_bounds__(NTHR, 2) mega_fwd(Args args) {
    extern __shared__ __attribute__((aligned(16))) unsigned char lds[];
    cg::grid_group grid = cg::this_grid();
    Frame F; F.lds = (LAS unsigned char*)lds; F.tid = threadIdx.x; F.lane = F.tid & 63; F.wave = __builtin_amdgcn_readfirstlane(F.tid >> 6); F.G = gridDim.x; F.bid = blockIdx.x; F.ws = args.ws;
    unsigned char* ws = args.ws;
    const int lo = args.ph_lo, hi = args.ph_hi;
#define IN(k) (lo <= (k) && (k) < hi)
#define SEAM(k) do { if (IN(k) && IN((k) + 1)) grid.sync(); FRESH(); } while (0)
#define FRESH() do { int t_ = threadIdx.x; asm volatile("" : "+v"(t_)); F.tid = t_; F.lane = t_ & 63; \
        F.wave = __builtin_amdgcn_readfirstlane(t_ >> 6); XN = (bf16*)(ws + WS_XN); FB = (bf16*)(ws + WS_FB); HID = (bf16*)(ws + WS_HID); } while (0)
    bf16* XN = (bf16*)(ws + WS_XN); bf16* FB = (bf16*)(ws + WS_FB); bf16* HID = (bf16*)(ws + WS_HID);
    FRESH();
    if (IN(PH_PRO) && !(XMASK >> PH_PRO & 1)) { p_prologue(F, args); } SEAM(PH_PRO);
    if (IN(PH_F1A) && !(XMASK >> PH_F1A & 1)) { pg8::Gemm g{XN, (const bf16*)(ws + WS_WA), TT, 2 * DFF, DM}; pg8::StaticOrder S; S.init(TT, 2 * DFF, F.G, F.bid); pg8::EpiSwiGLU E{HID, DFF};
        pg8::gemm_phase<pg8::EpiSwiGLU, pg8::StaticOrder, true, true>(F.lds, g, S, E); } SEAM(PH_F1A);
    if (IN(PH_F1B) && !(XMASK >> PH_F1B & 1)) { pg8::Gemm g{HID, (const bf16*)(ws + WS_WB), TT, DM, DFF}; pg8::StaticOrder S; S.init(TT, DM, F.G, F.bid); pg8::EpiPlain E{FB, DM};
        pg8::gemm_phase<pg8::EpiPlain, pg8::StaticOrder, true, true>(F.lds, g, S, E); } SEAM(PH_F1B);
    if (IN(PH_ROW1) && !(XMASK >> PH_ROW1 & 1)) { p_rowpass(F, FB, args.in[I_X], args.in[I_F1POST], 0.5f, args.out, args.in[I_MPRE], XN); } SEAM(PH_ROW1);
    if (IN(PH_INPROJ) && !(XMASK >> PH_INPROJ & 1)) { pg8::Gemm g{XN, (const bf16*)(ws + WS_WIN), TT, DINP, DM}; pg8::StaticOrder S; S.init(TT, DINP, F.G, F.bid);
        pg8::EpiInProj E{(bf16*)(ws + WS_CQ), (bf16*)(ws + WS_KATT), (bf16*)(ws + WS_VATT), (bf16*)(ws + WS_GRAW), (bf16*)(ws + WS_GZ), (float*)(ws + WS_SPEC)};
        pg8::gemm_phase<pg8::EpiInProj, pg8::StaticOrder, true, true>(F.lds, g, S, E); } SEAM(PH_INPROJ);
    if (IN(PH_PREP1) && !(XMASK >> PH_PREP1 & 1)) { p_prep1(F, args); } SEAM(PH_PREP1);
    if (IN(PH_QPROJ) && !(XMASK >> PH_QPROJ & 1)) { pg8::Gemm g{(const bf16*)(ws + WS_CQ), (const bf16*)(ws + WS_WQ), TT, 768, 256}; pg8::StaticOrder S; S.init(TT, 768, F.G, F.bid); pg8::EpiPlain E{(bf16*)(ws + WS_QRAW), 768};
        pg8::gemm_phase<pg8::EpiPlain, pg8::StaticOrder, true, true>(F.lds, g, S, E); } SEAM(PH_QPROJ);
    if (IN(PH_PREP2) && !(XMASK >> PH_PREP2 & 1)) { if (F.wave & 1) p_prep2(F, args, F.bid * 4 + (F.wave >> 1), F.G * 4);
        else for (int unit = F.bid * 4 + (F.wave >> 1); unit < 1024; unit += F.G * 4) gdn_pre_unit(F, unit, F.lds + (F.wave >> 1) * 33792); } SEAM(PH_PREP2);
    if (IN(PH_MIX) && !(XMASK >> PH_MIX & 1)) {
#if defined(GDN_NAIVE)
        if (F.bid < 8) p_gdn_naive(F, args, F.bid);
#else
        if (F.bid < 8) p_gdn_scan(F, args, F.bid);
#endif
        else p_dsa_naive(F, args, 8, F.G - 8); } SEAM(PH_MIX);
    if (IN(PH_OUTPROJ) && !(XMASK >> PH_OUTPROJ & 1)) { pg8::Gemm g{(const bf16*)(ws + WS_CAT), (const bf16*)(ws + WS_WOUT), TT, DM, DM}; pg8::StaticOrder S; S.init(TT, DM, F.G, F.bid); pg8::EpiPlain E{FB, DM};
        pg8::gemm_phase<pg8::EpiPlain, pg8::StaticOrder, true, true>(F.lds, g, S, E); } SEAM(PH_OUTPROJ);
    if (IN(PH_ROW2) && !(XMASK >> PH_ROW2 & 1)) { conv_ffn_weights(F, args, 1); p_rowpass(F, FB, args.out, args.in[I_MPOST], 1.0f, args.out, args.in[I_F2PRE], XN); } SEAM(PH_ROW2);
    if (IN(PH_F2A) && !(XMASK >> PH_F2A & 1)) { pg8::Gemm g{XN, (const bf16*)(ws + WS_WA), TT, 2 * DFF, DM}; pg8::StaticOrder S; S.init(TT, 2 * DFF, F.G, F.bid); pg8::EpiSwiGLU E{HID, DFF};
        pg8::gemm_phase<pg8::EpiSwiGLU, pg8::StaticOrder, true, true>(F.lds, g, S, E); } SEAM(PH_F2A);
    if (IN(PH_F2B) && !(XMASK >> PH_F2B & 1)) { pg8::Gemm g{HID, (const bf16*)(ws + WS_WB), TT, DM, DFF}; pg8::StaticOrder S; S.init(TT, DM, F.G, F.bid); pg8::EpiPlain E{FB, DM};
        pg8::gemm_phase<pg8::EpiPlain, pg8::StaticOrder, true, true>(F.lds, g, S, E); } SEAM(PH_F2B);
    if (IN(PH_ROW3) && !(XMASK >> PH_ROW3 & 1)) { p_rowpass(F, FB, args.out, args.in[I_F2POST], 0.5f, args.out, nullptr, nullptr); }
#undef IN
#undef SEAM
}

extern "C" void kernel_launch(void* const* d_in, const int* in_sizes, int n_in, void* d_out, int out_size, void* d_ws, size_t ws_size, hipStream_t stream) {
    static int grid = 0;
    if (grid == 0) {
        if (n_in != 24 || out_size != TT * DM || ws_size < WS_END) { fprintf(stderr, "kernel_launch: unexpected shapes (n_in %d out %d ws %zu)\n", n_in, out_size, ws_size); grid = -1; return; }
        int dev = 0, cus = 0, per_cu = 0;
        hipGetDevice(&dev); hipDeviceGetAttribute(&cus, hipDeviceAttributeMultiprocessorCount, dev);
        if (hipFuncSetAttribute((const void*)mega_fwd, hipFuncAttributeMaxDynamicSharedMemorySize, LDS_BYTES) != hipSuccess) { fprintf(stderr, "kernel_launch: hipFuncSetAttribute failed\n"); grid = -1; return; }
        if (hipOccupancyMaxActiveBlocksPerMultiprocessor(&per_cu, (const void*)mega_fwd, NTHR, LDS_BYTES) != hipSuccess || per_cu < 1) { fprintf(stderr, "kernel_launch: occupancy query says %d\n", per_cu); per_cu = 1; }
        (void)hipGetLastError();
        grid = cus * (per_cu < 1 ? 1 : 1);
        fprintf(stderr, "kernel_launch: cus %d per_cu %d grid %d\n", cus, per_cu, grid);
    }
    if (grid < 0) return;
    Args a{};
    for (int i = 0; i < 24; ++i) a.in[i] = (const float*)d_in[i];
    a.out = (float*)d_out; a.ws = (unsigned char*)d_ws;
    for (int i = 0; i < 32; ++i) a.invf_att[i] = 1.0f / powf(10000.0f, (float)i / 32.0f);
    for (int i = 0; i < 16; ++i) a.invf_idx[i] = 1.0f / powf(10000.0f, (float)i / 16.0f);
    a.ph_lo = 0; a.ph_hi = PH_N;
    void* kargs[] = {&a};
    hipError_t e = hipLaunchCooperativeKernel((const void*)mega_fwd, dim3(grid), dim3(NTHR), kargs, LDS_BYTES, stream);
    if (e != hipSuccess) fprintf(stderr, "kernel_launch: cooperative launch failed: %s (grid %d)\n", hipGetErrorString(e), grid);
}
```

```cpp
#include <hip/hip_runtime.h>
#include <hip/hip_bf16.h>
#include <hip/hip_fp16.h>
#include <cstdio>
#include <cstdint>
#include <cmath>
namespace pg8 {
#define PG8_LAS __attribute__((address_space(3)))
typedef unsigned short bf16_t;
typedef short bf16x8 __attribute__((ext_vector_type(8)));
typedef float f32x4 __attribute__((ext_vector_type(4)));
typedef unsigned u32x4 __attribute__((ext_vector_type(4)));
constexpr int BM = 256, BK = 64, HALF = 128, HTB = HALF * BK * 2  , STAGE_BYTES = 8 * HTB, NXCD = 8, WGM = 8;

__host__ __device__ __forceinline__ int lds_byte(int r, int c) { const int st = (r >> 4) * 2 + (c >> 5), rr = r & 15, cc = c & 31, ob = rr * 64 + cc * 2; return st * 1024 + (ob ^ (((ob >> 9) & 1) << 5)); }
__host__ __device__ __forceinline__ void stage_rc(int b, int& R, int& C) { const int st = b / 1024, sb = b % 1024, swz = sb ^ (((sb >> 9) & 1) << 5); R = (st >> 1) * 16 + swz / 64; C = (st & 1) * 32 + (swz % 64) / 2; }
__host__ __device__ __forceinline__ int perm32(int rho) { const int n = rho >> 4, i = rho & 15; return 8 * (i >> 2) + 4 * n + (i & 3); }

struct Unit { int pm, pn; };
struct Gemm { const bf16_t* A; const bf16_t* Bt; int M, N, K; };

struct StaticOrder {
    int nM, nN, nwg, G, c;
    __host__ __device__ void init(int M, int N, int G_, int c_) { nM = M / BM; nN = N / BM; nwg = nM * nN; G = G_; c = c_; }
    __host__ __device__ bool next(int i, Unit& u) const {
        const long L = (long)i * G + c; if (L >= nwg) return false;
        int wgid = (int)L; { const int q = nwg / NXCD, r = nwg % NXCD, xcd = wgid % NXCD, off = wgid / NXCD; wgid = (xcd < r ? xcd * (q + 1) : r * (q + 1) + (xcd - r) * q) + off; }
        const int nig = WGM * nN, gid = wgid / nig, fm = gid * WGM, gsz = (nM - fm) < WGM ? (nM - fm) : WGM;
        u.pm = fm + ((wgid % nig) % gsz); u.pn = (wgid % nig) / gsz; return true;
    }
    __device__ __forceinline__ void a_ready(const Unit&) const {}
    __device__ __forceinline__ void done(const Unit&) const {}
};

__device__ __forceinline__ unsigned cvt_pk_bf16(float lo, float hi) { unsigned r; asm volatile("v_cvt_pk_bf16_f32 %0, %1, %2" : "=v"(r) : "v"(lo), "v"(hi)); return r; }
typedef float f32x2 __attribute__((ext_vector_type(2)));
__device__ __forceinline__ u32x4 pack8(const f32x4 v0, const f32x4 v1) { u32x4 w; w.x = cvt_pk_bf16(v0[0], v0[1]); w.y = cvt_pk_bf16(v0[2], v0[3]); w.z = cvt_pk_bf16(v1[0], v1[1]); w.w = cvt_pk_bf16(v1[2], v1[3]); return w; }
struct EpiPlain {
    static constexpr bool PERM = true, AFTER_DRAIN = false;
    bf16_t* O; int ldc;
    __device__ __forceinline__ void operator()(const f32x4 (&acc)[2][2][4][2], const Unit& u, int wr, int wc, int fr, int fq) const {
        const int row0 = u.pm * BM + wr * 64 + fr, col0 = u.pn * BM + wc * 32 + 8 * fq;
#pragma unroll
        for (int ai = 0; ai < 2; ++ai)
#pragma unroll
            for (int m = 0; m < 4; ++m) { bf16_t* rowp = O + (size_t)(row0 + ai * HALF + m * 16) * ldc + col0;
#pragma unroll
                for (int bj = 0; bj < 2; ++bj) *(u32x4*)(rowp + bj * HALF) = pack8(acc[ai][bj][m][0], acc[ai][bj][m][1]); }
    }
};
__device__ __forceinline__ float silu_f(float g) { return g * __builtin_amdgcn_rcpf(1.0f + __builtin_amdgcn_exp2f(-1.4426950408889634f * g)); }
struct EpiSwiGLU {
    static constexpr bool PERM = true, AFTER_DRAIN = false;
    bf16_t* H; int ldh;
    __device__ __forceinline__ void operator()(const f32x4 (&acc)[2][2][4][2], const Unit& u, int wr, int wc, int fr, int fq) const {
        const int row0 = u.pm * BM + wr * 64 + fr, col0 = u.pn * HALF + wc * 32 + 8 * fq;
#pragma unroll
        for (int ai = 0; ai < 2; ++ai)
#pragma unroll
            for (int m = 0; m < 4; ++m) { bf16_t* rowp = H + (size_t)(row0 + ai * HALF + m * 16) * ldh + col0;
                f32x4 h0, h1;
#pragma unroll
                for (int i = 0; i < 4; ++i) { h0[i] = silu_f(acc[ai][0][m][0][i]) * acc[ai][1][m][0][i]; h1[i] = silu_f(acc[ai][0][m][1][i]) * acc[ai][1][m][1][i]; }
                *(u32x4*)rowp = pack8(h0, h1); }
    }
};
struct EpiInProj {
    static constexpr bool PERM = true, AFTER_DRAIN = false;
    bf16_t *CQ, *KATT, *VATT, *GRAW, *GZ; float* SPEC;
    __device__ __forceinline__ void operator()(const f32x4 (&acc)[2][2][4][2], const Unit& u, int wr, int wc, int fr, int fq) const {
        const int row0 = u.pm * BM + wr * 64 + fr; const int pn = u.pn;
        if (pn == 13) {
            const int col0 = wc * 32 + 8 * fq;
#pragma unroll
            for (int ai = 0; ai < 2; ++ai)
#pragma unroll
                for (int m = 0; m < 4; ++m) { float* rowp = SPEC + (size_t)(row0 + ai * HALF + m * 16) * 128 + col0;
                    *(f32x4*)rowp = acc[ai][0][m][0]; *(f32x4*)(rowp + 4) = acc[ai][0][m][1]; }
            return;
        }
        bf16_t* base; int ldc, ct;
        if (pn == 0) { base = CQ; ldc = 256; ct = 0; }
        else if (pn < 3) { base = KATT; ldc = 512; ct = (pn - 1) * 256; }
        else if (pn < 5) { base = VATT; ldc = 512; ct = (pn - 3) * 256; }
        else if (pn < 11) { base = GRAW; ldc = 1536; ct = (pn - 5) * 256; }
        else { base = GZ; ldc = 512; ct = (pn - 11) * 256; }
        const int col0 = ct + wc * 32 + 8 * fq;
#pragma unroll
        for (int ai = 0; ai < 2; ++ai)
#pragma unroll
            for (int m = 0; m < 4; ++m) { bf16_t* rowp = base + (size_t)(row0 + ai * HALF + m * 16) * ldc + col0;
#pragma unroll
                for (int bj = 0; bj < 2; ++bj) *(u32x4*)(rowp + bj * HALF) = pack8(acc[ai][bj][m][0], acc[ai][bj][m][1]); }
    }
};
template <class Epi, class Sched, bool ALIGN_EPI = false, bool SP2 = false>
__device__ __forceinline__ void gemm_phase(PG8_LAS unsigned char* lds, const Gemm g, const Sched& S, const Epi& E) {
    const int tid = threadIdx.x, wid = __builtin_amdgcn_readfirstlane(tid >> 6), lane = tid & 63, wr = wid >> 2, wc = wid & 3, fr = lane & 15, fq = lane >> 4;
    const int K = g.K, nt = K / BK;
    unsigned voffA[2], voffB[2];
#pragma unroll
    for (int i = 0; i < 2; ++i) { int R, C; stage_rc(tid * 16 + i * 8192, R, C); const int Rb = Epi::PERM ? ((R & ~31) + perm32(R & 31)) : R;
        voffA[i] = (unsigned)(R * K + C) * 2u; voffB[i] = (unsigned)(Rb * K + C) * 2u; }
    const size_t kstep = (size_t)(BK * 2);
    const size_t hstep = (size_t)HALF * K * 2;
    const size_t tstep = 2 * hstep;
    const unsigned ldsw = (unsigned)wid * 1024u;
    const int aoff = lds_byte(wr * 64 + fr, fq * 8), boff = lds_byte(wc * 32 + fr, fq * 8);
#define PG8_SA(b, h) (((b) * 2 + (h)) * HTB)
#define PG8_SB(b, h) ((4 + (b) * 2 + (h)) * HTB)
#define PG8_STAGE(bufoff, gbase, voff) do { _Pragma("unroll") for (int _i = 0; _i < 2; ++_i) \
        __builtin_amdgcn_global_load_lds((const unsigned*)((const char*)(gbase) + (voff)[_i]), (PG8_LAS unsigned*)(lds + (bufoff) + ldsw + _i * 8192), 16, 0, 0); } while (0)
#define PG8_LDA(dst, b, h) do { _Pragma("unroll") for (int m = 0; m < 4; ++m) _Pragma("unroll") for (int k = 0; k < 2; ++k) dst[m][k] = *(const PG8_LAS bf16x8*)(lds + PG8_SA(b, h) + aoff + m * 2048 + k * 1024); } while (0)
#define PG8_LDB(dst, b, h) do { _Pragma("unroll") for (int n = 0; n < 2; ++n) _Pragma("unroll") for (int k = 0; k < 2; ++k) dst[n][k] = *(const PG8_LAS bf16x8*)(lds + PG8_SB(b, h) + boff + n * 2048 + k * 1024); } while (0)
#define PG8_MMA(ai, bj, At, Bt) do { __builtin_amdgcn_s_setprio(1); _Pragma("unroll") for (int m = 0; m < 4; ++m) _Pragma("unroll") for (int n = 0; n < 2; ++n) _Pragma("unroll") for (int k = 0; k < 2; ++k) \
        acc[ai][bj][m][n] = __builtin_amdgcn_mfma_f32_16x16x32_bf16(Bt[n][k], At[m][k], acc[ai][bj][m][n], 0, 0, 0); __builtin_amdgcn_s_setprio(0); } while (0)
#define PG8_WAIT_V(n) asm volatile("s_waitcnt vmcnt(" #n ")" ::: "memory")
#define PG8_WAIT_L(n) asm volatile("s_waitcnt lgkmcnt(" #n ")" ::: "memory")
#define PG8_BAR __builtin_amdgcn_s_barrier()
#define PG8_SCHED __builtin_amdgcn_sched_barrier(0)
    Unit cur, nxt; int ui = 0;
    if (!S.next(0, cur)) return;
    f32x4 acc[2][2][4][2];
#pragma unroll
    for (int a = 0; a < 2; ++a)
#pragma unroll
        for (int b = 0; b < 2; ++b)
#pragma unroll
            for (int m = 0; m < 4; ++m)
#pragma unroll
                for (int n = 0; n < 2; ++n) acc[a][b][m][n] = (f32x4){0.f, 0.f, 0.f, 0.f};
    bf16x8 At[4][2], B0[2][2], B1[2][2];
    const char* cA = (const char*)g.A + (size_t)cur.pm * tstep; const char* cB = (const char*)g.Bt + (size_t)cur.pn * tstep;
    S.a_ready(cur);
    if constexpr (SP2) {
        PG8_STAGE(PG8_SB(0, 0), cB, voffB); PG8_STAGE(PG8_SB(0, 1), cB + hstep, voffB); PG8_STAGE(PG8_SA(0, 0), cA, voffA); PG8_STAGE(PG8_SA(0, 1), cA + hstep, voffA);
        if (wr == 1) PG8_BAR;
        PG8_WAIT_V(2); PG8_BAR;
        PG8_STAGE(PG8_SB(1, 0), cB + kstep, voffB); PG8_STAGE(PG8_SA(1, 0), cA + kstep, voffA); PG8_STAGE(PG8_SB(1, 1), cB + hstep + kstep, voffB);
        PG8_WAIT_V(6); PG8_BAR;
    } else {
        PG8_STAGE(PG8_SB(0, 0), cB, voffB); PG8_STAGE(PG8_SA(0, 0), cA, voffA); PG8_STAGE(PG8_SB(0, 1), cB + hstep, voffB); PG8_STAGE(PG8_SA(0, 1), cA + hstep, voffA);
        if (wr == 1) PG8_BAR;
        PG8_WAIT_V(4); PG8_BAR;
        PG8_STAGE(PG8_SB(1, 0), cB + kstep, voffB); PG8_STAGE(PG8_SA(1, 0), cA + kstep, voffA); PG8_STAGE(PG8_SB(1, 1), cB + hstep + kstep, voffB);
        PG8_WAIT_V(6); PG8_BAR;
    }
    for (;;) {
        const bool has_next = S.next(ui + 1, nxt);
        const char* nA = has_next ? (const char*)g.A + (size_t)nxt.pm * tstep : cA; const char* nB = has_next ? (const char*)g.Bt + (size_t)nxt.pn * tstep : cB;
        for (int t = 0; t < nt; t += 2) {
            const bool last = (t == nt - 2);
            const char* a1 = cA + (size_t)(t + 1) * kstep;
            const char* a2 = last ? nA : cA + (size_t)(t + 2) * kstep; const char* b2 = last ? nB : cB + (size_t)(t + 2) * kstep;
            const char* a3 = a2 + kstep; const char* b3 = b2 + kstep;
            if (last && has_next) S.a_ready(nxt);
            if constexpr (SP2) {
            PG8_LDB(B0, 0, 0); PG8_LDB(B1, 0, 1); PG8_SCHED; PG8_LDA(At, 0, 0); PG8_STAGE(PG8_SA(1, 1), a1 + hstep, voffA);
            PG8_WAIT_V(8); PG8_WAIT_L(0); PG8_BAR; PG8_MMA(0, 0, At, B0); PG8_MMA(0, 1, At, B1); PG8_BAR; PG8_SCHED;
            PG8_LDA(At, 0, 1); PG8_STAGE(PG8_SB(0, 0), b2, voffB); PG8_STAGE(PG8_SB(0, 1), b2 + hstep, voffB); PG8_STAGE(PG8_SA(0, 0), a2, voffA);
            PG8_WAIT_V(8); PG8_WAIT_L(0); PG8_BAR; PG8_MMA(1, 0, At, B0); PG8_MMA(1, 1, At, B1); PG8_BAR; PG8_SCHED;
            PG8_LDB(B0, 1, 0); PG8_LDB(B1, 1, 1); PG8_SCHED; PG8_LDA(At, 1, 0); PG8_STAGE(PG8_SA(0, 1), a2 + hstep, voffA);
            PG8_WAIT_V(8); PG8_WAIT_L(0); PG8_BAR; PG8_MMA(0, 0, At, B0); PG8_MMA(0, 1, At, B1); PG8_BAR; PG8_SCHED;
            PG8_LDA(At, 1, 1); PG8_STAGE(PG8_SB(1, 0), b3, voffB); PG8_STAGE(PG8_SB(1, 1), b3 + hstep, voffB); PG8_STAGE(PG8_SA(1, 0), a3, voffA);
            PG8_WAIT_V(8); PG8_WAIT_L(0); PG8_BAR; PG8_MMA(1, 0, At, B0); PG8_MMA(1, 1, At, B1); PG8_BAR; PG8_SCHED;
            } else {
            PG8_LDB(B0, 0, 0); PG8_SCHED; PG8_LDA(At, 0, 0); PG8_STAGE(PG8_SA(1, 1), a1 + hstep, voffA);
            PG8_WAIT_L(8); PG8_BAR; PG8_WAIT_L(0); PG8_MMA(0, 0, At, B0); PG8_BAR; PG8_SCHED;
            PG8_LDB(B1, 0, 1); PG8_STAGE(PG8_SB(0, 0), b2, voffB);
            PG8_BAR; PG8_WAIT_L(0); PG8_MMA(0, 1, At, B1); PG8_BAR;
            PG8_LDA(At, 0, 1); PG8_STAGE(PG8_SA(0, 0), a2, voffA);
            PG8_BAR; PG8_WAIT_L(0); PG8_MMA(1, 0, At, B0); PG8_BAR; PG8_SCHED;
            PG8_STAGE(PG8_SB(0, 1), b2 + hstep, voffB);
            PG8_WAIT_V(6); PG8_BAR; PG8_MMA(1, 1, At, B1); PG8_BAR;
            PG8_LDB(B0, 1, 0); PG8_SCHED; PG8_LDA(At, 1, 0); PG8_STAGE(PG8_SA(0, 1), a2 + hstep, voffA);
            PG8_WAIT_L(8); PG8_BAR; PG8_WAIT_L(0); PG8_MMA(0, 0, At, B0); PG8_BAR; PG8_SCHED;
            PG8_LDB(B1, 1, 1); PG8_STAGE(PG8_SB(1, 0), b3, voffB);
            PG8_BAR; PG8_WAIT_L(0); PG8_MMA(0, 1, At, B1); PG8_BAR;
            PG8_LDA(At, 1, 1); PG8_STAGE(PG8_SA(1, 0), a3, voffA);
            PG8_BAR; PG8_WAIT_L(0); PG8_MMA(1, 0, At, B0); PG8_BAR; PG8_SCHED;
            PG8_STAGE(PG8_SB(1, 1), b3 + hstep, voffB);
            PG8_WAIT_V(6); PG8_BAR; PG8_MMA(1, 1, At, B1); PG8_BAR;
            }
        }
        if constexpr (ALIGN_EPI) { if (wr == 0) PG8_BAR; }
        if constexpr (!Epi::AFTER_DRAIN) { E(acc, cur, wr, wc, fr, fq); S.done(cur); }
        if (!has_next) break;
#pragma unroll
        for (int a = 0; a < 2; ++a)
#pragma unroll
            for (int b = 0; b < 2; ++b)
#pragma unroll
                for (int m = 0; m < 4; ++m)
#pragma unroll
                    for (int n = 0; n < 2; ++n) acc[a][b][m][n] = (f32x4){0.f, 0.f, 0.f, 0.f};
        cur = nxt; cA = nA; cB = nB; ++ui;
        if constexpr (ALIGN_EPI) { if (wr == 1) PG8_BAR; }
    }
    PG8_WAIT_V(0);
    if constexpr (!ALIGN_EPI) { if (wr == 0) PG8_BAR; }
    PG8_BAR;
    if constexpr (Epi::AFTER_DRAIN) { E.fused(acc, cur, wr, wc, fr, fq, lds, wid, lane); S.done(cur); }
#undef PG8_SA
#undef PG8_SB
#undef PG8_STAGE
#undef PG8_LDA
#undef PG8_LDB
#undef PG8_MMA
#undef PG8_WAIT_V
#undef PG8_WAIT_L
#undef PG8_BAR
#undef PG8_SCHED
}
}
namespace attn_body {
using bf16=__hip_bfloat16;
using bf16x8=__attribute__((ext_vector_type(8)))short;
using s16x4=__attribute__((ext_vector_type(4)))short;
using f32x16=__attribute__((ext_vector_type(16)))float;
using u32x4=__attribute__((ext_vector_type(4)))unsigned;
constexpr int BATCH=2,NHEAD=8,SEQ=8192,D=64,DM=NHEAD*D,OPITCH=1024;
constexpr int NW=8,QBLK=32,QB=QBLK*NW,KVBLK=64,NQB=SEQ/QB;
constexpr int ATTN_PITCH=DM, ATTN_UNIT_ROWS=QB;
__device__ __forceinline__ int crow(int r,int hi){return (r&3)+8*(r>>2)+4*hi;}
#define SBAR() __builtin_amdgcn_sched_barrier(0)
__device__ __forceinline__ void cmask(f32x16&p0,f32x16&p1,int jb,int qrel,int hi){
  const float NEG=-INFINITY; int kb=64*jb+4*hi;
  #pragma unroll
  for(int r=0;r<16;++r){int kv=kb+(r&3)+8*(r>>2); if(kv>qrel)p0[r]=NEG; if(kv+32>qrel)p1[r]=NEG;}
}

constexpr int NSLOT=3, SLOTB=8192;
constexpr int LDS_K=0, LDS_V=NSLOT*SLOTB, LDS_WS=2*NSLOT*SLOTB, LDS_OST=LDS_WS+NW*64*4, LDS_MK=LDS_OST+NW*4096, MSLOTB=2048, LDS_BYTES=LDS_MK+NSLOT*MSLOTB;
constexpr float C2=0.125f*1.4426950408889634f;
__device__ __forceinline__ void glds16(const void*gsrc,unsigned lds_dst){unsigned keep;
  asm volatile("s_mov_b32 %0, m0\n\ts_mov_b32 m0, %2\n\ts_nop 0\n\tglobal_load_lds_dwordx4 %1, off\n\ts_mov_b32 m0, %0":"=&s"(keep):"v"(gsrc),"s"(lds_dst):"memory");}
__device__ __forceinline__ void glds16s(unsigned voff,const void*sbase,unsigned lds_dst){unsigned keep;
  asm volatile("s_mov_b32 %0, m0\n\ts_mov_b32 m0, %3\n\ts_nop 0\n\tglobal_load_lds_dwordx4 %1, %2\n\ts_mov_b32 m0, %0":"=&s"(keep):"v"(voff),"s"(sbase),"s"(lds_dst):"memory");}
__device__ __forceinline__ float fand_bits(float x,int m){return __builtin_bit_cast(float,__builtin_bit_cast(int,x)&m);}
__device__ __forceinline__ float max3f(float a,float b,float c){float r;asm("v_max3_f32 %0, %1, %2, %3":"=v"(r):"v"(a),"v"(b),"v"(c));return r;}
__device__ __forceinline__ float max2f(float a,float b){float r;asm("v_max_f32_e32 %0, %1, %2":"=v"(r):"v"(a),"v"(b));return r;}
__device__ __forceinline__ float fadd_s(float a,float b){float r;asm("v_add_f32_e32 %0, %1, %2":"=v"(r):"v"(a),"v"(b));return r;}
__device__ __forceinline__ float fsub_s(float a,float b){float r;asm("v_sub_f32_e32 %0, %1, %2":"=v"(r):"v"(a),"v"(b));return r;}
typedef float f32x2_t __attribute__((ext_vector_type(2))); typedef __bf16 bf16x2_t __attribute__((ext_vector_type(2)));
__device__ __forceinline__ unsigned cvtpk_s(float lo,float hi){f32x2_t v={lo,hi};bf16x2_t b=__builtin_convertvector(v,bf16x2_t);return __builtin_bit_cast(unsigned,b);}
#define WAIT_BAR(N) asm volatile("s_waitcnt vmcnt(" #N ") lgkmcnt(0)\n\ts_barrier":::"memory")

__device__ __forceinline__ void qkt(f32x16&p0,f32x16&p1,const char*Kslot,const bf16x8*qr,const f32x16&negm,int r32,int hi){
  const char*kb=Kslot+hi*1024+r32*16;
  #pragma unroll
  for(int d0=0;d0<4;++d0){
    const bf16x8 b0=*reinterpret_cast<const bf16x8*>(kb+d0*2048);
    const bf16x8 b1=*reinterpret_cast<const bf16x8*>(kb+d0*2048+512);
    if(d0==0){p0=__builtin_amdgcn_mfma_f32_32x32x16_bf16(b0,qr[0],negm,0,0,0);p1=__builtin_amdgcn_mfma_f32_32x32x16_bf16(b1,qr[0],negm,0,0,0);}
    else{p0=__builtin_amdgcn_mfma_f32_32x32x16_bf16(b0,qr[d0],p0,0,0,0);p1=__builtin_amdgcn_mfma_f32_32x32x16_bf16(b1,qr[d0],p1,0,0,0);}}
}
typedef __attribute__((address_space(3))) const char* lds_cptr;
typedef short v4i16_t __attribute__((ext_vector_type(4)));
__device__ __forceinline__ void kload8(bf16x8*kf,lds_cptr kp){
  kf[0]=*(const __attribute__((address_space(3))) bf16x8*)(kp);      kf[1]=*(const __attribute__((address_space(3))) bf16x8*)(kp+512);
  kf[2]=*(const __attribute__((address_space(3))) bf16x8*)(kp+2048); kf[3]=*(const __attribute__((address_space(3))) bf16x8*)(kp+2560);
  kf[4]=*(const __attribute__((address_space(3))) bf16x8*)(kp+4096); kf[5]=*(const __attribute__((address_space(3))) bf16x8*)(kp+4608);
  kf[6]=*(const __attribute__((address_space(3))) bf16x8*)(kp+6144); kf[7]=*(const __attribute__((address_space(3))) bf16x8*)(kp+6656);
}
__device__ __forceinline__ void kload2(bf16x8*kf,lds_cptr kp,int j){ kf[2*j]=*(const __attribute__((address_space(3))) bf16x8*)(kp+j*2048); kf[2*j+1]=*(const __attribute__((address_space(3))) bf16x8*)(kp+j*2048+512); }
__device__ __forceinline__ s16x4 vtr(lds_cptr p){ return __builtin_bit_cast(s16x4,__builtin_amdgcn_ds_read_tr16_b64_v4i16((__attribute__((address_space(3))) v4i16_t*)p)); }
__device__ __forceinline__ float rowmax(const f32x16&p0,const f32x16&p1){
  float a=max3f(p0[0],p0[1],p1[0]),b=max3f(p0[2],p0[3],p1[1]);a=max3f(a,p1[2],p1[3]);
  #pragma unroll
  for(int r=4;r<16;r+=4){a=max3f(a,p0[r],p0[r+1]);b=max3f(b,p0[r+2],p0[r+3]);a=max3f(a,p1[r],p1[r+1]);b=max3f(b,p1[r+2],p1[r+3]);}
  const float m=max2f(a,b);
  auto rr=__builtin_amdgcn_permlane32_swap(__float_as_uint(m),__float_as_uint(m),false,false);
  return max2f(__uint_as_float(rr[0]),__uint_as_float(rr[1]));
}
__device__ __forceinline__ void pv(f32x16*o,int vb,bf16x8 pa0,bf16x8 pa1,bf16x8 pa2,bf16x8 pa3){
  #pragma unroll
  for(int d0=0;d0<2;++d0){s16x4 lo[4],hi[4];
    #pragma unroll
    for(int ks=0;ks<4;++ks){
      asm volatile("ds_read_b64_tr_b16 %0,%1 offset:%c2":"=&v"(lo[ks]):"v"(vb),"i"(d0*4096+ks*1024):"memory");
      asm volatile("ds_read_b64_tr_b16 %0,%1 offset:%c2":"=&v"(hi[ks]):"v"(vb),"i"(d0*4096+ks*1024+512):"memory");}
    asm volatile("s_waitcnt lgkmcnt(0)":::"memory");SBAR();
    #define PK(k) (bf16x8){lo[k][0],lo[k][1],lo[k][2],lo[k][3],hi[k][0],hi[k][1],hi[k][2],hi[k][3]}
    o[d0]=__builtin_amdgcn_mfma_f32_32x32x16_bf16(pa0,PK(0),o[d0],0,0,0);
    o[d0]=__builtin_amdgcn_mfma_f32_32x32x16_bf16(pa1,PK(1),o[d0],0,0,0);
    o[d0]=__builtin_amdgcn_mfma_f32_32x32x16_bf16(pa2,PK(2),o[d0],0,0,0);
    o[d0]=__builtin_amdgcn_mfma_f32_32x32x16_bf16(pa3,PK(3),o[d0],0,0,0);
    #undef PK
  }
}

#ifndef ATTN_STORE16
#define ATTN_STORE16(p,v) (*(u32x4*)(p)=(v))
#endif
template<int THRL> __device__ __forceinline__ void attn_unit(int b,int h,int qb,const bf16*Q,const bf16*__restrict__ K,const bf16*__restrict__ V,bf16*O,const unsigned long long*__restrict__ MK,char*shm){
  const int tid=threadIdx.x,lane=tid&63,r32=lane&31,hi=lane>>5; const int wid=__builtin_amdgcn_readfirstlane(tid>>6);
  const long rowbase=(long)b*SEQ; const int q0=qb*QB;
  const bf16*Qw=Q+(rowbase+q0+wid*QBLK)*DM+h*D;
  const bf16*Kh=K+rowbase*DM+h*D,*Vh=V+rowbase*DM+h*D;
  const unsigned lds0=(unsigned)(uintptr_t)shm;
  float*wsf=(float*)(shm+LDS_WS)+wid*64;
  const bf16*ksrc=Kh+(long)lane*DM+wid*8;
  const bf16*vsrc=Vh+(long)(16*(wid&3)+(lane>>2))*DM+(wid>>2)*32+(lane&3)*8;
  const unsigned kdst=lds0+LDS_K+wid*1024, vdst=lds0+LDS_V+wid*1024;
  #define DMA_K(t,slot) glds16(ksrc+(long)(t)*KVBLK*DM,(unsigned)__builtin_amdgcn_readfirstlane(kdst+(slot)))
  #define DMA_V(t,slot) glds16(vsrc+(long)(t)*KVBLK*DM,(unsigned)__builtin_amdgcn_readfirstlane(vdst+(slot)))
  const unsigned long long*msrc=MK+((long)b*128)*SEQ+q0+wid*QBLK;
  const unsigned mdst=lds0+LDS_MK+wid*256;
  #define DMA_M(t,mslot) do{ if(lane<16) glds16s((unsigned)lane*16u,msrc+(long)(t)*SEQ,(unsigned)__builtin_amdgcn_readfirstlane(mdst+(mslot))); }while(0)
  #define MLOAD(mslot) do{ const unsigned long long mw_=mkl[(mslot)>>3]; mlo=(int)((unsigned)mw_>>(4*hi)); mhi=(int)((unsigned)(mw_>>32)>>(4*hi)); }while(0)
  #define MBIT(W,P) __builtin_amdgcn_sbfe((W),(P),1)
  #define MAND(x,W,P) fand_bits((x),MBIT(W,P))
  int mlo,mhi;
  const int vb0=(int)(lds0+LDS_V)+((lane>>4)&1)*32+(lane&3)*8+(4*hi+((lane&15)>>2))*64;
  const char*Kbase=shm+LDS_K; bf16x8 kf[8];
  const lds_cptr shm3=(lds_cptr)shm; const lds_cptr kp0=shm3+LDS_K+hi*1024+r32*16; const lds_cptr vp0=shm3+LDS_V+((lane>>4)&1)*32+(lane&3)*8+(4*hi+((lane&15)>>2))*64;
  const __attribute__((address_space(3))) unsigned long long*mkl=(const __attribute__((address_space(3))) unsigned long long*)(shm3+LDS_MK+wid*256+r32*8);
  const int NT=(q0+QB)/KVBLK;
  DMA_M(0,0);DMA_M(1,MSLOTB);DMA_K(0,0);DMA_V(0,0);DMA_K(1,SLOTB);
  bf16x8 qr[4];
  #pragma unroll
  for(int d0=0;d0<4;++d0)qr[d0]=*reinterpret_cast<const bf16x8*>(&Qw[(long)r32*DM+d0*16+hi*8]);
  float mhat=0.f,l_reg=0.f;f32x16 o[2];o[0]=f32x16{};o[1]=f32x16{};f32x16 negm=f32x16{};asm volatile("":"+v"(negm));
  const int qrel=wid*QBLK+r32;
  #define CMASK(P0,P1,t) do{int jb_=(t)-(NT-4); if(jb_>=0)cmask(P0,P1,jb_,qrel,hi);}while(0)
  bool resc=false;
  #define START(P0,P1) do{ const float rm=rowmax(P0,P1); resc=false; \
    { const float dl=rm; mhat=fadd_s(mhat,dl); \
      _Pragma("unroll") for(int r=0;r<16;++r){P0[r]=fsub_s(P0[r],dl);P1[r]=fsub_s(P1[r],dl);} \
      _Pragma("unroll") for(int r=0;r<16;++r)negm[r]=-mhat; asm volatile("":"+v"(negm)); } \
    _Pragma("unroll") for(int r=0;r<16;++r)P0[r]=__builtin_amdgcn_exp2f(P0[r]); }while(0)
  #define RESC() do{ if(resc){ asm volatile("s_waitcnt lgkmcnt(0)":::"memory"); \
      _Pragma("unroll") for(int d_=0;d_<2;++d_) _Pragma("unroll") for(int r=0;r<16;++r)o[d_][r]*=wsf[crow(r,hi)]; } }while(0)
  f32x16 pA0,pA1,pB0,pB1;
  int sl_prev=0,sl_cur=0,sl_next=SLOTB;
  #define ROT() do{sl_prev=sl_cur;sl_cur=sl_next;sl_next=(sl_next==(NSLOT-1)*SLOTB)?0:sl_next+SLOTB;}while(0)
  DMA_K(2,2*SLOTB);
  WAIT_BAR(3);
  qkt(pA0,pA1,Kbase,qr,negm,r32,hi);asm volatile("s_nop 15\n\ts_nop 7":"+v"(pA0),"+v"(pA1));CMASK(pA0,pA1,0);
  START(pA0,pA1);
  _Pragma("unroll") for(int r=0;r<16;++r)pA1[r]=__builtin_amdgcn_exp2f(pA1[r]);
  MLOAD(0); _Pragma("unroll") for(int r=0;r<16;++r){ pA0[r]=MAND(pA0[r],mlo,(r&3)+8*(r>>2)); pA1[r]=MAND(pA1[r],mhi,(r&3)+8*(r>>2)); }
  WAIT_BAR(0);
  DMA_K(3,0);DMA_V(1,SLOTB);DMA_M(2,2*MSLOTB);
  ROT();
  kload8(kf,kp0+sl_cur);
  WAIT_BAR(3);
  s16x4 vlo[8],vhi[8]; u32x4 pw0,pw1,pw2,pw3;
  #define PKW(P,B) cvtpk_s(P[B],P[B+1])
  #define PAF(k) __builtin_bit_cast(bf16x8,pw##k)
  #define VFR(i) (bf16x8){vlo[i][0],vlo[i][1],vlo[i][2],vlo[i][3],vhi[i][0],vhi[i][1],vhi[i][2],vhi[i][3]}
  #define PIN(x) asm volatile("":"+v"(x))
  #define MX3(a,b,c) __builtin_fmaxf(__builtin_fmaxf((a),(b)),(c))
  #define GAPA(MF,A0,A1,A2,A3,W0,W1,PW) do{ MF; sacc+=A0; sacc+=A1; sacc+=A2; sacc+=A3; PIN(sacc); W0; W1; PIN(PW); SBAR(); }while(0)
  #define EX(v) __builtin_amdgcn_exp2f(v)
  #define GAPB(MF,X,B,W) do{ MF; X[B]=MAND(EX(X[B]),W,2*(B)); X[B+1]=MAND(EX(X[B+1]),W,2*(B)+1); X[B+2]=MAND(EX(X[B+2]),W,2*(B)+2); X[B+3]=MAND(EX(X[B+3]),W,2*(B)+3); PIN(X); SBAR(); }while(0)
  #define VRD(i) do{ vlo[i]=vtr(vp_+(((i)>>2)*4096+((i)&3)*1024)); vhi[i]=vtr(vp_+(((i)>>2)*4096+((i)&3)*1024+512)); }while(0)
  #define KRD(G,j) do{ if(G){ kload2(kf,kp0+sl_next,j); SBAR(); } }while(0)
  #define STEP(C0,C1,P0,P1,t,GK,GV,GL,GM) do{ SBAR(); \
    const lds_cptr vp_=vp0+sl_prev; \
    VRD(0); SBAR(); float sacc=(P0[0]+P0[1]); \
    GAPA(C0=__builtin_amdgcn_mfma_f32_32x32x16_bf16(kf[0],qr[0],negm,0,0,0), P0[2],P0[3],P0[4],P0[5],     pw0[0]=PKW(P0,0), pw0[1]=PKW(P0,2), pw0); \
    VRD(4); SBAR(); GAPA(C1=__builtin_amdgcn_mfma_f32_32x32x16_bf16(kf[1],qr[0],negm,0,0,0), P0[6],P0[7],P0[8],P0[9],     pw0[2]=PKW(P0,4), pw0[3]=PKW(P0,6), pw0); \
    VRD(1); SBAR(); GAPA(C0=__builtin_amdgcn_mfma_f32_32x32x16_bf16(kf[2],qr[1],C0,0,0,0),   P0[10],P0[11],P0[12],P0[13], pw1[0]=PKW(P0,8), pw1[1]=PKW(P0,10), pw1); \
    VRD(5); SBAR(); GAPA(C1=__builtin_amdgcn_mfma_f32_32x32x16_bf16(kf[3],qr[1],C1,0,0,0),   P0[14],P0[15],P1[0],P1[1],   pw1[2]=PKW(P0,12),pw1[3]=PKW(P0,14), pw1); \
    VRD(2); SBAR(); GAPA(C0=__builtin_amdgcn_mfma_f32_32x32x16_bf16(kf[4],qr[2],C0,0,0,0),   P1[2],P1[3],P1[4],P1[5],     pw2[0]=PKW(P1,0), pw2[1]=PKW(P1,2), pw2); \
    VRD(6); SBAR(); GAPA(C1=__builtin_amdgcn_mfma_f32_32x32x16_bf16(kf[5],qr[2],C1,0,0,0),   P1[6],P1[7],P1[8],P1[9],     pw2[2]=PKW(P1,4), pw2[3]=PKW(P1,6), pw2); \
    VRD(3); SBAR(); GAPA(C0=__builtin_amdgcn_mfma_f32_32x32x16_bf16(kf[6],qr[3],C0,0,0,0),   P1[10],P1[11],P1[12],P1[13], pw3[0]=PKW(P1,8), pw3[1]=PKW(P1,10), pw3); \
    VRD(7); SBAR(); GAPA(C1=__builtin_amdgcn_mfma_f32_32x32x16_bf16(kf[7],qr[3],C1,0,0,0),   P1[14],P1[15],0.f,0.f,       pw3[2]=PKW(P1,12),pw3[3]=PKW(P1,14), pw3); \
    l_reg+=sacc; \
    if(GK){DMA_K((t)+3,sl_cur);} if(GV){DMA_V((t)+1,sl_next);} if(GM){DMA_M((t)+2,sl_prev>>2);} MLOAD(sl_cur>>2); \
    CMASK(C0,C1,t); \
    { float a=MX3(C0[0],C0[1],C1[0]),b=MX3(C0[2],C0[3],C1[1]); a=MX3(a,C1[2],C1[3]); \
      _Pragma("unroll") for(int r=4;r<16;r+=4){a=MX3(a,C0[r],C0[r+1]);b=MX3(b,C0[r+2],C0[r+3]);a=MX3(a,C1[r],C1[r+1]);b=MX3(b,C1[r+2],C1[r+3]);} \
      float rm=__builtin_fmaxf(a,b); { auto rr=__builtin_amdgcn_permlane32_swap(__float_as_uint(rm),__float_as_uint(rm),false,false); rm=__builtin_fmaxf(__uint_as_float(rr[0]),__uint_as_float(rr[1])); } \
      resc=false; \
      if(__builtin_expect(__any(rm>(float)THRL),0)){ const float dl=__builtin_fmaxf(rm,0.f); mhat+=dl; \
        _Pragma("unroll") for(int r=0;r<16;++r){C0[r]-=dl;C1[r]-=dl;} \
        _Pragma("unroll") for(int r=0;r<16;++r)negm[r]=-mhat; asm volatile("":"+v"(negm)); \
        const float f=__builtin_amdgcn_exp2f(-dl); l_reg*=f; if(hi==0)wsf[r32]=f; resc=true; } } \
    SBAR(); \
    GAPB(o[0]=__builtin_amdgcn_mfma_f32_32x32x16_bf16(PAF(0),VFR(0),o[0],0,0,0), C0,0,mlo); \
    GAPB(o[1]=__builtin_amdgcn_mfma_f32_32x32x16_bf16(PAF(0),VFR(4),o[1],0,0,0), C0,4,mlo); \
    KRD(GL,0); GAPB(o[0]=__builtin_amdgcn_mfma_f32_32x32x16_bf16(PAF(1),VFR(1),o[0],0,0,0), C0,8,mlo); \
    KRD(GL,1); GAPB(o[1]=__builtin_amdgcn_mfma_f32_32x32x16_bf16(PAF(1),VFR(5),o[1],0,0,0), C0,12,mlo); \
    KRD(GL,2); GAPB(o[0]=__builtin_amdgcn_mfma_f32_32x32x16_bf16(PAF(2),VFR(2),o[0],0,0,0), C1,0,mhi); \
    KRD(GL,3); GAPB(o[1]=__builtin_amdgcn_mfma_f32_32x32x16_bf16(PAF(2),VFR(6),o[1],0,0,0), C1,4,mhi); \
    GAPB(o[0]=__builtin_amdgcn_mfma_f32_32x32x16_bf16(PAF(3),VFR(3),o[0],0,0,0), C1,8,mhi); \
    GAPB(o[1]=__builtin_amdgcn_mfma_f32_32x32x16_bf16(PAF(3),VFR(7),o[1],0,0,0), C1,12,mhi); \
    }while(0)
  int t=1;
  #undef CMASK
  #define CMASK(P0,P1,t) do{}while(0)
  for(;t+5<NT;t+=2){
    STEP(pB0,pB1,pA0,pA1,t,true,true,true,true);     WAIT_BAR(3); RESC(); ROT();
    STEP(pA0,pA1,pB0,pB1,t+1,true,true,true,true);   WAIT_BAR(3); RESC(); ROT();
  }
  #undef CMASK
  #define CMASK(P0,P1,t) do{int jb_=(t)-(NT-4); if(jb_>=0)cmask(P0,P1,jb_,qrel,hi);}while(0)
  #define ENDW(tt) do{ if((tt)+3<NT){WAIT_BAR(3);} else if((tt)+2<NT){WAIT_BAR(2);} else {WAIT_BAR(0);} }while(0)
  for(;t+1<NT;t+=2){
    STEP(pB0,pB1,pA0,pA1,t,(t+3<NT),(t+1<NT),(t+1<NT),(t+2<NT));       ENDW(t);   RESC(); ROT();
    STEP(pA0,pA1,pB0,pB1,t+1,(t+4<NT),(t+2<NT),(t+2<NT),(t+3<NT));     ENDW(t+1); RESC(); ROT();
  }
  STEP(pB0,pB1,pA0,pA1,NT-1,false,false,false,false); RESC();
  { float sacc=pB0[0]+pB0[1]; _Pragma("unroll") for(int r=2;r<16;++r)sacc+=pB0[r]; _Pragma("unroll") for(int r=0;r<16;++r)sacc+=pB1[r]; l_reg+=sacc;
    pw0=(u32x4){PKW(pB0,0),PKW(pB0,2),PKW(pB0,4),PKW(pB0,6)};pw1=(u32x4){PKW(pB0,8),PKW(pB0,10),PKW(pB0,12),PKW(pB0,14)};pw2=(u32x4){PKW(pB1,0),PKW(pB1,2),PKW(pB1,4),PKW(pB1,6)};pw3=(u32x4){PKW(pB1,8),PKW(pB1,10),PKW(pB1,12),PKW(pB1,14)};
    SBAR(); pv(o,vb0+sl_cur,PAF(0),PAF(1),PAF(2),PAF(3)); }
  #undef PKW
  #undef PAF
  #undef VFR
  #undef PIN
  #undef MX3
  #undef GAPA
  #undef GAPB
  #undef EX
  #undef VRD
  #undef KRD
  #undef STEP
  #undef ENDW
  {auto rr=__builtin_amdgcn_permlane32_swap(__float_as_uint(l_reg),__float_as_uint(l_reg),false,false);l_reg=__uint_as_float(rr[0])+__uint_as_float(rr[1]);}
  if(hi==0)wsf[32+r32]=l_reg;asm volatile("s_waitcnt lgkmcnt(0)":::"memory");
  float rli[16];
  #pragma unroll
  for(int r=0;r<16;++r)rli[r]=__builtin_amdgcn_rcpf(wsf[32+crow(r,hi)]);
  bf16*Ow=O+(rowbase+q0+wid*QBLK)*OPITCH+h*D;
  { bf16*stg=(bf16*)(shm+LDS_OST)+wid*2048;
    #pragma unroll
    for(int r=0;r<16;++r){const int orow=crow(r,hi);
      #pragma unroll
      for(int d0=0;d0<2;++d0)stg[orow*64+d0*32+r32]=__float2bfloat16(o[d0][r]*rli[r]);}
    asm volatile("s_waitcnt lgkmcnt(0)":::"memory");
    #pragma unroll
    for(int i=0;i<4;++i){const int row=i*8+(lane>>3),ch=lane&7; const u32x4 v=*(const u32x4*)(stg+row*64+ch*8); ATTN_STORE16(Ow+(long)row*OPITCH+ch*8,v);} }
  asm volatile("s_waitcnt lgkmcnt(0)\n\ts_barrier":::"memory");
  #undef DMA_K
  #undef DMA_V
  #undef DMA_M
  #undef MLOAD
  #undef MBIT
  #undef MAND
  #undef CMASK
  #undef START
  #undef RESC
  #undef ROT
}
constexpr int ATTN_LDS_BYTES=LDS_BYTES;
struct AttnTensors { const bf16* Q; const bf16* K; const bf16* V; bf16* O; const unsigned long long* MK; };
struct AttnUnit { int bh; int qb; };
struct StaticOrder {
  int vcu, G;
  __device__ __forceinline__ explicit StaticOrder(int grid,int block):vcu((grid%8==0)?(block%8)*(grid/8)+block/8:block),G(grid){}
  __device__ __forceinline__ bool next(int i,AttnUnit&u)const{ const int pu=vcu+(i>>1)*G; if(pu>=256)return false; const int s=pu&15; u.bh=pu>>4; u.qb=(i&1)?31-s:s; return true; }
  __device__ __forceinline__ void a_ready(const AttnUnit&)const{}
  __device__ __forceinline__ void done(const AttnUnit&)const{}
};
template<class Sched,int THRL=8> __device__ __forceinline__ void attn_phase(char*lds,const AttnTensors&T,const Sched&S){
  AttnUnit u;
  for(int i=0;S.next(i,u);++i){ S.a_ready(u); attn_unit<THRL>(u.bh/NHEAD,u.bh%NHEAD,u.qb,T.Q,T.K,T.V,T.O,T.MK,lds); S.done(u); }
}
#undef SBAR
#undef WAIT_BAR
}
constexpr int NWAVES = 8, NTHR = 512;
constexpr int BATCH = 2, SEQ = 8192, TT = BATCH * SEQ, DM = 1024, DFF = 2816, DIN = 3404, DINP = 3584;
constexpr int TOPK = 256;
constexpr float NORM_EPS = 1e-6f;
constexpr float C2 = 0.125f * 1.4426950408889634f;
constexpr size_t MiB = 1u << 20;
constexpr size_t WS_CTL = 0, CTL_ZERO_BYTES = 1 * MiB;
constexpr size_t WS_WA = 1 * MiB, WS_WB = 12 * MiB, WS_WIN = 35 * MiB / 2, WS_WQ = 49 * MiB / 2, WS_WOUT = 25 * MiB;
constexpr size_t WS_BETA = 27 * MiB, WS_GLOG = 27 * MiB + MiB / 4, WS_WIDX = 27 * MiB + MiB / 2, WS_GF = 27 * MiB + 3 * MiB / 4, WS_KIDX = 29 * MiB;
constexpr size_t WS_XN = 32 * MiB, WS_FB = 64 * MiB, WS_HID = 96 * MiB;
constexpr size_t WS_CQ = 64 * MiB, WS_KATT = 72 * MiB, WS_VATT = 88 * MiB, WS_GRAW = 104 * MiB, WS_GZ = 152 * MiB, WS_SPEC = 168 * MiB;
constexpr size_t WS_QF = 176 * MiB, WS_KF = 192 * MiB, WS_KTF = 208 * MiB, WS_VTF = 224 * MiB;
constexpr size_t WS_QRAW = 104 * MiB, WS_Q = 32 * MiB, WS_QIDX = 48 * MiB;
constexpr size_t WS_MASK = 240 * MiB, WS_CAT = 104 * MiB;
constexpr size_t WS_WF = 136 * MiB, WS_UC = 1 * MiB, WS_QKF = 17 * MiB;
constexpr size_t WS_END = 256 * MiB;
constexpr int RING_BYTES = 131072, LDS_BYTES = 151552, LDS_MISC_OFF = LDS_BYTES - 64;
constexpr int CW_BAR = 4096;

#define GAS __attribute__((address_space(1)))
#define LAS __attribute__((address_space(3)))
typedef unsigned short bf16;
typedef unsigned v4u __attribute__((ext_vector_type(4)));
typedef unsigned v2u __attribute__((ext_vector_type(2)));
typedef float f32x4 __attribute__((ext_vector_type(4)));
#define LDS_WAIT() asm volatile("s_waitcnt lgkmcnt(0)" ::: "memory")

__device__ __forceinline__ unsigned f2bf(float f) { unsigned u = __builtin_bit_cast(unsigned, f); return (u + 0x7fffu + ((u >> 16) & 1u)) >> 16; }
__device__ __forceinline__ unsigned pk2(float lo, float hi) { return f2bf(lo) | (f2bf(hi) << 16); }
__device__ __forceinline__ float bf2f(unsigned short h) { return __builtin_bit_cast(float, (unsigned)h << 16); }
__device__ __forceinline__ float bflo(unsigned w) { return __builtin_bit_cast(float, w << 16); }
__device__ __forceinline__ float bfhi(unsigned w) { return __builtin_bit_cast(float, w & 0xffff0000u); }
#define SWZ_XOR(x_, m_) __builtin_bit_cast(float, __builtin_amdgcn_ds_swizzle(__builtin_bit_cast(int, (x_)), (((m_) << 10) | 0x1f)))
__device__ __forceinline__ float xor32f(float v) { auto rr = __builtin_amdgcn_permlane32_swap(__builtin_bit_cast(unsigned, v), __builtin_bit_cast(unsigned, v), false, false); return __builtin_bit_cast(float, (unsigned)(rr[0] ^ rr[1] ^ __builtin_bit_cast(unsigned, v))); }
__device__ __forceinline__ float wave_sum(float v) {
    v += SWZ_XOR(v, 1); v += SWZ_XOR(v, 2); v += SWZ_XOR(v, 4); v += SWZ_XOR(v, 8); v += SWZ_XOR(v, 16);
    auto rr = __builtin_amdgcn_permlane32_swap(__builtin_bit_cast(unsigned, v), __builtin_bit_cast(unsigned, v), false, false);
    return __builtin_bit_cast(float, (unsigned)rr[0]) + __builtin_bit_cast(float, (unsigned)rr[1]);
}
__device__ __forceinline__ float wave_max(float v) {
    v = fmaxf(v, SWZ_XOR(v, 1)); v = fmaxf(v, SWZ_XOR(v, 2)); v = fmaxf(v, SWZ_XOR(v, 4)); v = fmaxf(v, SWZ_XOR(v, 8)); v = fmaxf(v, SWZ_XOR(v, 16));
    auto rr = __builtin_amdgcn_permlane32_swap(__builtin_bit_cast(unsigned, v), __builtin_bit_cast(unsigned, v), false, false);
    return fmaxf(__builtin_bit_cast(float, (unsigned)rr[0]), __builtin_bit_cast(float, (unsigned)rr[1]));
}
__device__ __forceinline__ float sigmoid_f(float x) { return __builtin_amdgcn_rcpf(1.0f + __builtin_amdgcn_exp2f(-1.4426950408889634f * x)); }
__device__ __forceinline__ float silu2(float x) { return x * sigmoid_f(x); }
__device__ __forceinline__ void rope_cs(float pos, float invf, float& c, float& s) {
    const float ang = pos * invf; double rev = (double)ang * 0.15915494309189535; rev -= __builtin_floor(rev); const float r = (float)rev;
    s = __builtin_amdgcn_sinf(r); c = __builtin_amdgcn_cosf(r);
}

struct Args { const float* in[24]; float* out; unsigned char* ws; float invf_att[32]; float invf_idx[16]; int ph_lo, ph_hi; };
enum { I_X = 0, I_F1PRE, I_F1POST, I_F1G, I_F1U, I_F1D, I_MPRE, I_MPOST, I_WIN, I_QAG, I_WQB, I_WQIB, I_KLG, I_KLB, I_CONV, I_ALOG, I_DTB, I_GOUTG, I_WOUT, I_F2PRE, I_F2POST, I_F2G, I_F2U, I_F2D };

struct Frame {
    LAS unsigned char* lds;
    int tid, lane, wave, G, bid;
    unsigned char* ws;
};

__device__ __forceinline__ void transpose_item(const float* W, int Nsrc, int K, bf16* WT, int n0, int sc, int k0, LAS float* scr, int lane) {
#pragma unroll 8
    for (int i = 0; i < 32; ++i) { const int kk = 2 * i + (lane >> 5); scr[kk * 33 + (lane & 31)] = sc >= 0 ? W[(size_t)(k0 + kk) * Nsrc + sc] : 0.f; }
    LDS_WAIT(); asm volatile("" ::: "memory");
    const int c = lane & 7;
#pragma unroll
    for (int j = 0; j < 4; ++j) { const int n = (lane >> 3) + 8 * j; const LAS float* s = scr + (8 * c) * 33 + n;
        v4u o; o.x = pk2(s[0 * 33], s[1 * 33]); o.y = pk2(s[2 * 33], s[3 * 33]); o.z = pk2(s[4 * 33], s[5 * 33]); o.w = pk2(s[6 * 33], s[7 * 33]);
        *(GAS v4u*)(WT + (size_t)(n0 + n) * K + k0 + 8 * c) = o; }
    LDS_WAIT(); asm volatile("" ::: "memory");
}
__device__ __forceinline__ int inproj_src(int r) {
    if (r < 1280) return r;
    if (r < 3328) return r + 68;
    if (r < 3392) return 1280 + (r - 3328);
    if (r < 3396) return 1344 + (r - 3392);
    if (r < 3404) return r;
    return -1;
}
__device__ __forceinline__ void rms_row_to_bf16(const float* xrow, const float* g, bf16* orow, int lane) {
    const GAS f32x4* xr = (const GAS f32x4*)xrow + lane; const GAS f32x4* gr = (const GAS f32x4*)g + lane;
    f32x4 v[4]; float s = 0.f;
#pragma unroll
    for (int j = 0; j < 4; ++j) { v[j] = xr[64 * j]; s += (v[j].x * v[j].x + v[j].y * v[j].y) + (v[j].z * v[j].z + v[j].w * v[j].w); }
    const float rstd = 1.0f / sqrtf(wave_sum(s) * (1.f / DM) + NORM_EPS);
    GAS v2u* o8 = (GAS v2u*)orow + lane;
#pragma unroll
    for (int j = 0; j < 4; ++j) { const f32x4 gg = gr[64 * j]; v2u o; o.x = pk2(v[j].x * rstd * gg.x, v[j].y * rstd * gg.y); o.y = pk2(v[j].z * rstd * gg.z, v[j].w * rstd * gg.w); o8[64 * j] = o; }
}
__device__ __forceinline__ void conv_ffn_weights(Frame& F, const Args& A, int f) {
    LAS float* scr = (LAS float*)(F.lds + F.wave * 16384);
    const int gw = F.bid * NWAVES + F.wave, NGW = F.G * NWAVES, lane = F.lane;
    bf16* WA = (bf16*)(F.ws + WS_WA); bf16* WB = (bf16*)(F.ws + WS_WB);
    constexpr int I_A = (DM / 64) * (2 * DFF / 32), I_B = (DFF / 64) * (DM / 32);
    for (int it = gw; it < I_A + I_B; it += NGW) {
        int r = it;
        if (r < I_A) { const int nblk = 2 * DFF / 32, kb = r / nblk, nb = r % nblk, n0 = nb * 32;
            const int tile = n0 >> 8, within = n0 & 255; const bool up = within >= 128; const int sc = tile * 128 + (within & 127) + (lane & 31);
            const float* W = A.in[f ? (up ? I_F2U : I_F2G) : (up ? I_F1U : I_F1G)];
            transpose_item(W, DFF, DM, WA, n0, sc, kb * 64, scr, lane); continue; }
        r -= I_A;
        { const int nblk = DM / 32, kb = r / nblk, nb = r % nblk, n0 = nb * 32;
            transpose_item(A.in[f ? I_F2D : I_F1D], DM, DFF, WB, n0, n0 + (lane & 31), kb * 64, scr, lane); }
    }
}
__device__ __forceinline__ void p_prologue(Frame& F, const Args& A) {
    LAS float* scr = (LAS float*)(F.lds + F.wave * 16384);
    const int gw = F.bid * NWAVES + F.wave, NGW = F.G * NWAVES, lane = F.lane;
    bf16* WIN = (bf16*)(F.ws + WS_WIN); bf16* WQ = (bf16*)(F.ws + WS_WQ); bf16* WOUT = (bf16*)(F.ws + WS_WOUT);
    conv_ffn_weights(F, A, 0);
    constexpr int I_IN = (DM / 64) * (DINP / 32), I_Q = (256 / 64) * (768 / 32), I_O = (DM / 64) * (DM / 32);
    constexpr int NITEMS = I_IN + I_Q + I_O;
    for (int it = gw; it < NITEMS; it += NGW) {
        int r = it;
        if (r < I_IN) { const int nblk = DINP / 32, kb = r / nblk, nb = r % nblk, n0 = nb * 32;
            transpose_item(A.in[I_WIN], DIN, DM, WIN, n0, inproj_src(n0 + (lane & 31)), kb * 64, scr, lane); continue; }
        r -= I_IN;
        if (r < I_Q) { const int nblk = 768 / 32, kb = r / nblk, nb = r % nblk, n0 = nb * 32;
            if (n0 < 512) transpose_item(A.in[I_WQB], 512, 256, WQ, n0, n0 + (lane & 31), kb * 64, scr, lane);
            else transpose_item(A.in[I_WQIB], 256, 256, WQ, n0, n0 - 512 + (lane & 31), kb * 64, scr, lane);
            continue; }
        r -= I_Q;
        { const int nblk = DM / 32, kb = r / nblk, nb = r % nblk, n0 = nb * 32;
            transpose_item(A.in[I_WOUT], DM, DM, WOUT, n0, n0 + (lane & 31), kb * 64, scr, lane); }
    }
    bf16* XN = (bf16*)(F.ws + WS_XN);
    for (int m = gw; m < TT; m += NGW) rms_row_to_bf16(A.in[I_X] + (size_t)m * DM, A.in[I_F1PRE], XN + (size_t)m * DM, lane);
}

__device__ __forceinline__ void p_rowpass(Frame& F, const bf16* FB, const float* xin, const float* gpost, float scale, float* xout, const float* gnext, bf16* XN) {
    const int gw = F.bid * NWAVES + F.wave, NGW = F.G * NWAVES, lane = F.lane;
    for (int m = gw; m < TT; m += NGW) {
        const GAS v4u* fr = (const GAS v4u*)(FB + (size_t)m * DM) + lane;
        float f[16]; float s = 0.f;
#pragma unroll
        for (int j = 0; j < 2; ++j) { const v4u w = fr[64 * j];
            f[8 * j + 0] = bflo(w.x); f[8 * j + 1] = bfhi(w.x); f[8 * j + 2] = bflo(w.y); f[8 * j + 3] = bfhi(w.y); f[8 * j + 4] = bflo(w.z); f[8 * j + 5] = bfhi(w.z); f[8 * j + 6] = bflo(w.w); f[8 * j + 7] = bfhi(w.w); }
#pragma unroll
        for (int i = 0; i < 16; ++i) s += f[i] * f[i];
        const float rstd = 1.0f / sqrtf(wave_sum(s) * (1.f / DM) + NORM_EPS) * scale;
        float xn[16]; float s2 = 0.f;
#pragma unroll
        for (int j = 0; j < 2; ++j)
#pragma unroll
            for (int q = 0; q < 2; ++q) { const int c = 512 * j + 8 * lane + 4 * q; const f32x4 xi = *(const GAS f32x4*)(xin + (size_t)m * DM + c); const f32x4 gp = *(const GAS f32x4*)(gpost + c);
                f32x4 o;
#pragma unroll
                for (int i = 0; i < 4; ++i) { o[i] = xi[i] + f[8 * j + 4 * q + i] * rstd * gp[i]; xn[8 * j + 4 * q + i] = o[i]; s2 += o[i] * o[i]; }
                *(GAS f32x4*)(xout + (size_t)m * DM + c) = o; }
        if (gnext) {
            const float r2 = 1.0f / sqrtf(wave_sum(s2) * (1.f / DM) + NORM_EPS);
#pragma unroll
            for (int j = 0; j < 2; ++j) { const int c = 512 * j + 8 * lane; const f32x4 g0 = *(const GAS f32x4*)(gnext + c), g1 = *(const GAS f32x4*)(gnext + c + 4);
                v4u o; o.x = pk2(xn[8 * j + 0] * r2 * g0[0], xn[8 * j + 1] * r2 * g0[1]); o.y = pk2(xn[8 * j + 2] * r2 * g0[2], xn[8 * j + 3] * r2 * g0[3]);
                o.z = pk2(xn[8 * j + 4] * r2 * g1[0], xn[8 * j + 5] * r2 * g1[1]); o.w = pk2(xn[8 * j + 6] * r2 * g1[2], xn[8 * j + 7] * r2 * g1[3]);
                *(GAS v4u*)(XN + (size_t)m * DM + c) = o; }
        }
    }
}

__device__ __forceinline__ size_t fragA_idx(int unit, int i, int d) { const int rb = i >> 5, r = i & 31, ks = d >> 4, x = d & 15, c = x >> 3, h = (x >> 2) & 1, b = x & 3; return ((size_t)(unit * 2 + rb) * 8 + ks) * 512 + (h * 32 + r) * 8 + 4 * c + b; }
__device__ __forceinline__ size_t fragT_idx(int unit, int d, int j) { const int tc = d >> 5, r = d & 31, ks = j >> 4, y = j & 15, c = y >> 3, h = (y >> 2) & 1, b = y & 3; return ((size_t)(unit * 4 + tc) * 4 + ks) * 512 + (h * 32 + r) * 8 + 4 * c + b; }

__device__ __forceinline__ void p_prep1(Frame& F, const Args& A) {
    const int gw = F.bid * NWAVES + F.wave, NGW = F.G * NWAVES, lane = F.lane;
    bf16* CQ = (bf16*)(F.ws + WS_CQ); bf16* KATT = (bf16*)(F.ws + WS_KATT); const bf16* GRAW = (const bf16*)(F.ws + WS_GRAW); const float* SPEC = (const float*)(F.ws + WS_SPEC);
    __half* KIDX = (__half*)(F.ws + WS_KIDX); float* BETA = (float*)(F.ws + WS_BETA); float* GLOG = (float*)(F.ws + WS_GLOG); float* WIDX = (float*)(F.ws + WS_WIDX);
    bf16* QF = (bf16*)(F.ws + WS_QF); bf16* KF = (bf16*)(F.ws + WS_KF); bf16* KTF = (bf16*)(F.ws + WS_KTF); bf16* VTF = (bf16*)(F.ws + WS_VTF);
    const float* convw = A.in[I_CONV];
    for (int m = gw; m < TT; m += NGW) {
        const int t = m & (SEQ - 1); const float pos = (float)t;
        { GAS v2u* p = (GAS v2u*)(CQ + (size_t)m * 256) + lane; const v2u w = *p; const float a0 = bflo(w.x), a1 = bfhi(w.x), a2 = bflo(w.y), a3 = bfhi(w.y);
          const float rstd = 1.0f / sqrtf(wave_sum(a0 * a0 + a1 * a1 + a2 * a2 + a3 * a3) * (1.f / 256) + NORM_EPS); const f32x4 g = *(const GAS f32x4*)(A.in[I_QAG] + 4 * lane);
          v2u o; o.x = pk2(a0 * rstd * g[0], a1 * rstd * g[1]); o.y = pk2(a2 * rstd * g[2], a3 * rstd * g[3]); *p = o; }
        { const int hd = lane >> 3, d0 = (lane & 7) * 4; GAS v2u* p1 = (GAS v2u*)(KATT + (size_t)m * 512 + hd * 64 + d0); GAS v2u* p2 = (GAS v2u*)(KATT + (size_t)m * 512 + hd * 64 + d0 + 32);
          const v2u w1 = *p1, w2 = *p2; float x1[4] = {bflo(w1.x), bfhi(w1.x), bflo(w1.y), bfhi(w1.y)}, x2[4] = {bflo(w2.x), bfhi(w2.x), bflo(w2.y), bfhi(w2.y)}; float o1[4], o2[4];
#pragma unroll
          for (int i = 0; i < 4; ++i) { float c, s; rope_cs(pos, A.invf_att[d0 + i], c, s); o1[i] = x1[i] * c - x2[i] * s; o2[i] = x2[i] * c + x1[i] * s; }
          v2u a, b; a.x = pk2(o1[0], o1[1]); a.y = pk2(o1[2], o1[3]); b.x = pk2(o2[0], o2[1]); b.y = pk2(o2[2], o2[3]); *p1 = a; *p2 = b; }
        { const float v = SPEC[(size_t)m * 128 + lane]; const float mu = wave_sum(v) * (1.f / 64); const float xc = v - mu; const float var = wave_sum(xc * xc) * (1.f / 64);
          const float y = xc * (1.0f / sqrtf(var + NORM_EPS)) * A.in[I_KLG][lane] + A.in[I_KLB][lane];
          const float part = SWZ_XOR(y, 16); float c, s; rope_cs(pos, A.invf_idx[lane & 15], c, s);
          float o = y; if (lane < 16) o = y * c - part * s; else if (lane < 32) o = y * c + part * s;
          KIDX[(size_t)m * 64 + lane] = __float2half(o); }
        if (lane < 4) { const float gb = SPEC[(size_t)m * 128 + 68 + lane], ga = SPEC[(size_t)m * 128 + 72 + lane];
          BETA[(size_t)m * 4 + lane] = sigmoid_f(gb);
          const float xx = ga + A.in[I_DTB][lane]; const float sp = fmaxf(xx, 0.f) + log1pf(__expf(-fabsf(xx)));
          GLOG[(size_t)m * 4 + lane] = -__expf(A.in[I_ALOG][lane]) * sp;
          WIDX[(size_t)m * 4 + lane] = SPEC[(size_t)m * 128 + 64 + lane]; }
    }
    for (int blk = gw; blk < TT / 8; blk += NGW) {
        const int b = blk >> 10, n = (blk & 1023) >> 3, a = blk & 7; const int t0 = 64 * n + 8 * a; const size_t m0 = (size_t)b * SEQ + t0;
        const int gsub = lane >> 4, ks = (lane & 15) >> 1, hh = lane & 1; const int ch0 = 16 * ks + 4 * hh;
#pragma unroll 1
        for (int pass = 0; pass < 3; ++pass) {
            const int cbase = pass * 512 + gsub * 128 + ch0; const int unit = (b * 4 + gsub) * 128 + n;
            float wc[4][8];
#pragma unroll
            for (int jj = 0; jj < 4; ++jj) { const f32x4 w0 = *(const GAS f32x4*)(convw + jj * 1536 + cbase), w1 = *(const GAS f32x4*)(convw + jj * 1536 + cbase + 8);
#pragma unroll
                for (int e = 0; e < 4; ++e) { wc[jj][e] = w0[e]; wc[jj][4 + e] = w1[e]; } }
            float y[8][8];
#pragma unroll
            for (int tk = 0; tk < 8; ++tk)
#pragma unroll
                for (int e = 0; e < 8; ++e) y[tk][e] = 0.f;
#pragma unroll
            for (int rr = 0; rr < 11; ++rr) { float x[8];
                if (t0 - 3 + rr >= 0) { const v2u w0 = *(const GAS v2u*)(GRAW + (m0 - 3 + rr) * 1536 + cbase), w1 = *(const GAS v2u*)(GRAW + (m0 - 3 + rr) * 1536 + cbase + 8);
                    x[0] = bflo(w0.x); x[1] = bfhi(w0.x); x[2] = bflo(w0.y); x[3] = bfhi(w0.y); x[4] = bflo(w1.x); x[5] = bfhi(w1.x); x[6] = bflo(w1.y); x[7] = bfhi(w1.y); }
                else {
#pragma unroll
                    for (int e = 0; e < 8; ++e) x[e] = 0.f; }
#pragma unroll
                for (int jj = 0; jj < 4; ++jj) { const int tk = rr - jj; if (tk >= 0 && tk < 8) {
#pragma unroll
                    for (int e = 0; e < 8; ++e) y[tk][e] += wc[jj][e] * x[e]; } } }
#pragma unroll
            for (int tk = 0; tk < 8; ++tk) { float ss = 0.f;
#pragma unroll
                for (int e = 0; e < 8; ++e) { y[tk][e] = silu2(y[tk][e]); ss += y[tk][e] * y[tk][e]; }
                if (pass < 2) { ss += SWZ_XOR(ss, 1); ss += SWZ_XOR(ss, 2); ss += SWZ_XOR(ss, 4); ss += SWZ_XOR(ss, 8); const float r = 1.0f / sqrtf(ss + NORM_EPS);
#pragma unroll
                    for (int e = 0; e < 8; ++e) y[tk][e] *= r; } }
            if (pass < 2) { bf16* dst = pass == 0 ? QF : KF;
#pragma unroll
                for (int tk = 0; tk < 8; ++tk) { const int i = 8 * a + tk; v4u o; o.x = pk2(y[tk][0], y[tk][1]); o.y = pk2(y[tk][2], y[tk][3]); o.z = pk2(y[tk][4], y[tk][5]); o.w = pk2(y[tk][6], y[tk][7]);
                    *(GAS v4u*)(dst + ((size_t)(unit * 2 + (i >> 5)) * 8 + ks) * 512 + (hh * 32 + (i & 31)) * 8) = o; } }
            if (pass >= 1) { bf16* dst = pass == 1 ? KTF : VTF;
#pragma unroll
                for (int e = 0; e < 8; ++e) { const int d = ch0 + (e & 3) + 8 * (e >> 2); const size_t base = ((size_t)(unit * 4 + (d >> 5)) * 4 + (a >> 1)) * 512 + (d & 31) * 8 + 4 * (a & 1);
                    v2u o0, o1; o0.x = pk2(y[0][e], y[1][e]); o0.y = pk2(y[2][e], y[3][e]); o1.x = pk2(y[4][e], y[5][e]); o1.y = pk2(y[6][e], y[7][e]);
                    *(GAS v2u*)(dst + base) = o0; *(GAS v2u*)(dst + base + 32 * 8) = o1; } }
        }
    }
}
__device__ __forceinline__ void p_prep2(Frame& F, const Args& A, int gw, int NGW) {
    const int lane = F.lane;
    const bf16* QRAW = (const bf16*)(F.ws + WS_QRAW); bf16* Q = (bf16*)(F.ws + WS_Q); __half* QIDX = (__half*)(F.ws + WS_QIDX);
    for (int m = gw; m < TT; m += NGW) {
        const int t = m & (SEQ - 1); const float pos = (float)t;
        { const int hd = lane >> 3, d0 = (lane & 7) * 4; const v2u w1 = *(const GAS v2u*)(QRAW + (size_t)m * 768 + hd * 64 + d0), w2 = *(const GAS v2u*)(QRAW + (size_t)m * 768 + hd * 64 + d0 + 32);
          float x1[4] = {bflo(w1.x), bfhi(w1.x), bflo(w1.y), bfhi(w1.y)}, x2[4] = {bflo(w2.x), bfhi(w2.x), bflo(w2.y), bfhi(w2.y)}; float o1[4], o2[4];
#pragma unroll
          for (int i = 0; i < 4; ++i) { float c, s; rope_cs(pos, A.invf_att[d0 + i], c, s); o1[i] = (x1[i] * c - x2[i] * s) * C2; o2[i] = (x2[i] * c + x1[i] * s) * C2; }
          v2u a, b; a.x = pk2(o1[0], o1[1]); a.y = pk2(o1[2], o1[3]); b.x = pk2(o2[0], o2[1]); b.y = pk2(o2[2], o2[3]);
          *(GAS v2u*)(Q + (size_t)m * 512 + hd * 64 + d0) = a; *(GAS v2u*)(Q + (size_t)m * 512 + hd * 64 + d0 + 32) = b; }
        { const int hd = lane >> 4, i = lane & 15; const bf16* src = QRAW + (size_t)m * 768 + 512 + hd * 64; __half* dst = QIDX + (size_t)m * 256 + hd * 64;
          const float x1 = bf2f(src[i]), x2 = bf2f(src[i + 16]); float c, s; rope_cs(pos, A.invf_idx[i], c, s);
          dst[i] = __float2half(x1 * c - x2 * s); dst[i + 16] = __float2half(x2 * c + x1 * s);
          dst[32 + 2 * i] = __float2half(bf2f(src[32 + 2 * i])); dst[33 + 2 * i] = __float2half(bf2f(src[33 + 2 * i])); }
    }
}

__device__ __forceinline__ unsigned sortable(float x) { const unsigned u = __builtin_bit_cast(unsigned, x); return (u & 0x80000000u) ? ~u : (u | 0x80000000u); }
__device__ __forceinline__ void p_dsa_naive(Frame& F, const Args& A, int first_blk, int nblk) {
    const int tid = F.tid, lane = F.lane, wave = F.wave;
    const bf16* Q = (const bf16*)(F.ws + WS_Q); const bf16* KATT = (const bf16*)(F.ws + WS_KATT); const bf16* VATT = (const bf16*)(F.ws + WS_VATT);
    const __half* QIDX = (const __half*)(F.ws + WS_QIDX); const __half* KIDX = (const __half*)(F.ws + WS_KIDX); const float* WIDX = (const float*)(F.ws + WS_WIDX);
    unsigned long long* MASK = (unsigned long long*)(F.ws + WS_MASK); bf16* CAT = (bf16*)(F.ws + WS_CAT);
    LAS float* qi = (LAS float*)(F.lds);
    LAS float* wv = (LAS float*)(F.lds + 1024);
    LAS int* cntb = (LAS int*)(F.lds + 1280);
    LAS unsigned long long* mw = (LAS unsigned long long*)(F.lds + 2048);
    LAS int* pref = (LAS int*)(F.lds + 4096);
    LAS int* sel = (LAS int*)(F.lds + 8192);
    LAS float* P = (LAS float*)(F.lds + 16384);
    int par = 0;
    for (int m = F.bid - first_blk; m < TT; m += nblk) {
        const int b = m >> 13, t = m & (SEQ - 1);
        __syncthreads();
        if (tid < 256) qi[tid] = __half2float(QIDX[(size_t)m * 256 + tid]);
        if (tid < 4) wv[tid] = WIDX[(size_t)m * 4 + tid];
        __syncthreads();
        unsigned key[16];
#pragma unroll
        for (int j = 0; j < 16; ++j) { const int s = tid + 512 * j; key[j] = 0u;
            if (s <= t) { const v4u* kp = (const v4u*)(KIDX + ((size_t)b * SEQ + s) * 64); float d0 = 0.f, d1 = 0.f, d2 = 0.f, d3 = 0.f;
#pragma unroll
                for (int c = 0; c < 8; ++c) { const v4u w = kp[c]; const unsigned ww[4] = {w.x, w.y, w.z, w.w};
#pragma unroll
                    for (int e = 0; e < 4; ++e) { const __half2 h2 = __builtin_bit_cast(__half2, ww[e]); const float k0 = __low2float(h2), k1 = __high2float(h2); const int d = c * 8 + e * 2;
                        d0 += qi[d] * k0 + qi[d + 1] * k1; d1 += qi[64 + d] * k0 + qi[64 + d + 1] * k1; d2 += qi[128 + d] * k0 + qi[128 + d + 1] * k1; d3 += qi[192 + d] * k0 + qi[192 + d + 1] * k1; } }
                const float sc = wv[0] * fmaxf(d0, 0.f) + wv[1] * fmaxf(d1, 0.f) + wv[2] * fmaxf(d2, 0.f) + wv[3] * fmaxf(d3, 0.f);
                key[j] = sortable(sc); } }
#define BCOUNT(PRED, OUT) do { int c_ = 0; _Pragma("unroll") for (int j = 0; j < 16; ++j) { const int s = tid + 512 * j; (void)s; c_ += (int)__popcll(__ballot(PRED)); } \
            if (lane == 0) cntb[par * 8 + wave] = c_; __syncthreads(); int t_ = 0; _Pragma("unroll") for (int w_ = 0; w_ < 8; ++w_) t_ += cntb[par * 8 + w_]; par ^= 1; OUT = t_; } while (0)
        unsigned vstar = 1u; int cutoff = SEQ;
        if (t + 1 > TOPK) {
            unsigned cur = 0u;
            for (int bit = 31; bit >= 0; --bit) { const unsigned v = cur | (1u << bit); int c; BCOUNT(key[j] >= v, c); if (c >= TOPK) cur = v; }
            vstar = cur; int cgt; BCOUNT(key[j] > vstar, cgt); const int need = TOPK - cgt;
            int lo = 0, hi = SEQ - 1;
            while (lo < hi) { const int mid = (lo + hi) >> 1; int c; BCOUNT(key[j] == vstar && s <= mid, c); if (c >= need) hi = mid; else lo = mid + 1; }
            cutoff = lo;
        }
        bool selj[16];
#pragma unroll
        for (int j = 0; j < 16; ++j) { const int s = tid + 512 * j; selj[j] = (t + 1 > TOPK) ? (key[j] > vstar || (key[j] == vstar && s <= cutoff)) : (s <= t);
            const unsigned long long bm = __ballot(selj[j]); if (lane == 0) { mw[8 * j + wave] = bm; MASK[((size_t)(b * 128 + 8 * j + wave)) * SEQ + t] = bm; } }
        __syncthreads();
        if (wave == 0) { int c0 = (int)__popcll(mw[2 * lane]), c1 = (int)__popcll(mw[2 * lane + 1]); int s = c0 + c1, inc = s;
#pragma unroll
            for (int o = 1; o < 64; o <<= 1) { const int u = __shfl_up(inc, o); if (lane >= o) inc += u; }
            const int ex = inc - s; pref[2 * lane] = ex; pref[2 * lane + 1] = ex + c0; }
        __syncthreads();
#pragma unroll
        for (int j = 0; j < 16; ++j) if (selj[j]) { const int wd = 8 * j + wave; const int pos = pref[wd] + (int)__popcll(mw[wd] & ((1ull << lane) - 1ull)); if (pos < TOPK) sel[pos] = tid + 512 * j; }
        __syncthreads();
        const int nsel = (t + 1 < TOPK) ? t + 1 : TOPK;
        { const int h = wave; float qv[64];
          { const v4u* qp = (const v4u*)(Q + (size_t)m * 512 + h * 64);
#pragma unroll
            for (int c = 0; c < 8; ++c) { const v4u w = qp[c]; qv[8 * c] = bflo(w.x); qv[8 * c + 1] = bfhi(w.x); qv[8 * c + 2] = bflo(w.y); qv[8 * c + 3] = bfhi(w.y); qv[8 * c + 4] = bflo(w.z); qv[8 * c + 5] = bfhi(w.z); qv[8 * c + 6] = bflo(w.w); qv[8 * c + 7] = bfhi(w.w); } }
          float lg[4];
#pragma unroll
          for (int kk = 0; kk < 4; ++kk) { const int idx = lane + 64 * kk; lg[kk] = -INFINITY;
            if (idx < nsel) { const int s = sel[idx]; const v4u* kp = (const v4u*)(KATT + ((size_t)b * SEQ + s) * 512 + h * 64); float d = 0.f;
#pragma unroll
                for (int c = 0; c < 8; ++c) { const v4u w = kp[c]; d += qv[8 * c] * bflo(w.x) + qv[8 * c + 1] * bfhi(w.x) + qv[8 * c + 2] * bflo(w.y) + qv[8 * c + 3] * bfhi(w.y) + qv[8 * c + 4] * bflo(w.z) + qv[8 * c + 5] * bfhi(w.z) + qv[8 * c + 6] * bflo(w.w) + qv[8 * c + 7] * bfhi(w.w); }
                lg[kk] = d; } }
          const float mx = wave_max(fmaxf(fmaxf(lg[0], lg[1]), fmaxf(lg[2], lg[3]))); float ps = 0.f;
#pragma unroll
          for (int kk = 0; kk < 4; ++kk) { const float p = __builtin_amdgcn_exp2f(lg[kk] - mx); ps += p; P[h * 256 + lane + 64 * kk] = p; }
          const float tot = wave_sum(ps);
          LDS_WAIT(); asm volatile("" ::: "memory");
          float acc = 0.f;
          for (int idx = 0; idx < nsel; ++idx) { const int s = sel[idx]; acc += P[h * 256 + idx] * bf2f(VATT[((size_t)b * SEQ + s) * 512 + h * 64 + lane]); }
          CAT[(size_t)m * 1024 + h * 64 + lane] = (bf16)f2bf(acc / tot); }
    }
#undef BCOUNT
}

__device__ __forceinline__ void p_gdn_naive(Frame& F, const Args& A, int bh) {
    const int tid = F.tid, lane = F.lane, wave = F.wave; const int b = bh >> 2, h = bh & 3; const int e = tid & 127, ds = tid >> 7;
    const bf16* QF = (const bf16*)(F.ws + WS_QF); const bf16* KF = (const bf16*)(F.ws + WS_KF); const bf16* VTF = (const bf16*)(F.ws + WS_VTF); const bf16* GZ = (const bf16*)(F.ws + WS_GZ);
    const float* BETA = (const float*)(F.ws + WS_BETA); const float* GLOG = (const float*)(F.ws + WS_GLOG); bf16* CAT = (bf16*)(F.ws + WS_CAT);
    LAS float* red1 = (LAS float*)(F.lds + 65536); LAS float* red2 = (LAS float*)(F.lds + 65536 + 2048); LAS float* small = (LAS float*)(F.lds + 65536 + 4096);
    float S[32];
#pragma unroll
    for (int i = 0; i < 32; ++i) S[i] = 0.f;
    const float gout = A.in[I_GOUTG][e];
    for (int t = 0; t < SEQ; ++t) {
        const size_t row = (size_t)b * SEQ + t; const int unit = bh * 128 + (t >> 6), i = t & 63;
        float kk[32], qq[32];
#pragma unroll
        for (int c = 0; c < 32; ++c) { kk[c] = bf2f(KF[fragA_idx(unit, i, ds * 32 + c)]); qq[c] = bf2f(QF[fragA_idx(unit, i, ds * 32 + c)]); }
        const float v = bf2f(VTF[fragT_idx(unit, e, i)]); const float beta = BETA[row * 4 + h]; const float a = __expf(GLOG[row * 4 + h]);
        float part = 0.f;
#pragma unroll
        for (int c = 0; c < 32; ++c) part += kk[c] * S[c];
        red1[ds * 128 + e] = part; __syncthreads();
        const float kS = (red1[e] + red1[128 + e]) + (red1[256 + e] + red1[384 + e]);
        const float vn = beta * (v - a * kS);
        float po = 0.f;
#pragma unroll
        for (int c = 0; c < 32; ++c) { S[c] = a * S[c] + kk[c] * vn; po += qq[c] * S[c]; }
        red2[ds * 128 + e] = po; __syncthreads();
        float o = 0.f;
        if (ds == 0) { o = ((red2[e] + red2[128 + e]) + (red2[256 + e] + red2[384 + e])) * 0.08838834764831845f; const float ss = wave_sum(o * o); if (lane == 0) small[wave] = ss; }
        __syncthreads();
        if (ds == 0) { const float rstd = 1.0f / sqrtf((small[0] + small[1]) * (1.f / 128) + NORM_EPS); const float z = bf2f(GZ[row * 512 + h * 128 + e]);
            CAT[row * 1024 + 512 + h * 128 + e] = (bf16)f2bf(o * rstd * gout * silu2(z)); }
    }
}

typedef short bf16x8 __attribute__((ext_vector_type(8)));
typedef float f32x16 __attribute__((ext_vector_type(16)));
typedef float f32x2_t __attribute__((ext_vector_type(2))); typedef __bf16 bf16x2_t __attribute__((ext_vector_type(2)));
__device__ __forceinline__ unsigned cvtpk(float lo, float hi) { f32x2_t v = {lo, hi}; bf16x2_t b = __builtin_convertvector(v, bf16x2_t); return __builtin_bit_cast(unsigned, b); }
#define PACK8(A_, B_) __builtin_bit_cast(bf16x8, (v4u){cvtpk((A_)[(B_)], (A_)[(B_) + 1]), cvtpk((A_)[(B_) + 2], (A_)[(B_) + 3]), cvtpk((A_)[(B_) + 4], (A_)[(B_) + 5]), cvtpk((A_)[(B_) + 6], (A_)[(B_) + 7])})
#define MFMA32(a_, b_, c_) __builtin_amdgcn_mfma_f32_32x32x16_bf16((a_), (b_), (c_), 0, 0, 0)
constexpr int GF_STRIDE = 192;
constexpr float GDN_SCALE = 0.08838834764831845f;
__device__ __forceinline__ void gdn_pre_unit(Frame& F, int unit, LAS unsigned char* wl) {
    int lane = F.lane; asm volatile("" : "+v"(lane));
    const int c = lane & 31, half = lane >> 5;
    const int bh = unit >> 7, n = unit & 127, b = bh >> 2, h = bh & 3; const size_t m0 = (size_t)b * SEQ + 64 * n;
    const bf16* QF = (const bf16*)(F.ws + WS_QF); const bf16* KF = (const bf16*)(F.ws + WS_KF); const bf16* KTF = (const bf16*)(F.ws + WS_KTF); const bf16* VTF = (const bf16*)(F.ws + WS_VTF);
    const float* BETA = (const float*)(F.ws + WS_BETA); const float* GLOG = (const float*)(F.ws + WS_GLOG);
    bf16* WF = (bf16*)(F.ws + WS_WF); bf16* UC = (bf16*)(F.ws + WS_UC); bf16* QKF = (bf16*)(F.ws + WS_QKF); float* GF = (float*)(F.ws + WS_GF);
    { unsigned wb_ = (unsigned)(uintptr_t)wl; asm volatile("" : "+v"(wb_)); wl = (LAS unsigned char*)(uintptr_t)wb_; }
    LAS float* AT = (LAS float*)wl; LAS float* Tl = (LAS float*)(wl + 16384); LAS float* gcl = (LAS float*)(wl + 32768); LAS float* btl = gcl + 64; LAS float* bgl = gcl + 128;
    const float gl = GLOG[(m0 + lane) * 4 + h], bt = BETA[(m0 + lane) * 4 + h];
    float gc = gl;
#pragma unroll
    for (int o = 1; o < 64; o <<= 1) { const float u = __builtin_bit_cast(float, __builtin_amdgcn_ds_bpermute((lane - o) << 2, __builtin_bit_cast(int, gc))); if (lane >= o) gc += u; }
    const float gc63 = __builtin_bit_cast(float, __builtin_amdgcn_readlane(__builtin_bit_cast(int, gc), 63));
    gcl[lane] = gc; btl[lane] = bt; bgl[lane] = bt * __expf(gc);
    GF[(size_t)unit * GF_STRIDE + lane] = __expf(gc) * GDN_SCALE; GF[(size_t)unit * GF_STRIDE + 64 + lane] = __expf(gc63 - gc); if (lane == 0) GF[(size_t)unit * GF_STRIDE + 128] = __expf(gc63);
    bf16x8 kf[2][8];
#pragma unroll
    for (int rb = 0; rb < 2; ++rb)
#pragma unroll
        for (int ks = 0; ks < 8; ++ks) kf[rb][ks] = *(const GAS bf16x8*)(KF + ((size_t)(unit * 2 + rb) * 8 + ks) * 512 + lane * 8);
    LDS_WAIT(); asm volatile("" ::: "memory");
#pragma unroll
    for (int tile = 0; tile < 3; ++tile) { const int tr = tile >= 1, tc = tile >= 2; f32x16 acc = {};
#pragma unroll
        for (int ks = 0; ks < 8; ++ks) acc = MFMA32(kf[tr][ks], kf[tc][ks], acc);
        const int C = 32 * tc + c; const float gcC = gcl[C];
#pragma unroll
        for (int reg = 0; reg < 16; ++reg) { const int R = 32 * tr + (reg & 3) + 8 * (reg >> 2) + 4 * half; AT[C * 64 + R] = btl[R] * acc[reg] * __expf(gcl[R] - gcC); } }
#pragma unroll
    for (int tile = 0; tile < 3; ++tile) { const int tj = tile >= 2, ti = tile >= 1; f32x16 acc = {};
#pragma unroll
        for (int ks = 0; ks < 8; ++ks) acc = MFMA32(kf[tj][ks], *(const GAS bf16x8*)(QF + ((size_t)(unit * 2 + ti) * 8 + ks) * 512 + lane * 8), acc);
        asm volatile("" ::: "memory");
        const int I = 32 * ti + c; const float gcI = gcl[I]; float v[16];
#pragma unroll
        for (int reg = 0; reg < 16; ++reg) { const int J = 32 * tj + (reg & 3) + 8 * (reg >> 2) + 4 * half; v[reg] = (J <= I) ? acc[reg] * __expf(gcI - gcl[J]) * GDN_SCALE : 0.f; }
        *(GAS bf16x8*)(QKF + ((size_t)(unit * 2 + ti) * 4 + 2 * tj) * 512 + lane * 8) = PACK8(v, 0);
        *(GAS bf16x8*)(QKF + ((size_t)(unit * 2 + ti) * 4 + 2 * tj + 1) * 512 + lane * 8) = PACK8(v, 8); }
    LDS_WAIT(); asm volatile("" ::: "memory");
    Tl[63 * 64 + lane] = (lane == 63) ? 1.f : 0.f;
#pragma unroll 1
    for (int j = 62; j >= 0; --j) { float acc = (lane == j) ? 1.f : 0.f;
#pragma unroll 4
        for (int k = j + 1; k < 64; ++k) acc -= Tl[k * 64 + lane] * AT[j * 64 + k];
        Tl[j * 64 + lane] = acc; }
    LDS_WAIT(); asm volatile("" ::: "memory");
    LAS unsigned char* TbF = wl; LAS unsigned char* TbgF = wl + 8192;
    { const int rb = lane >> 5, r = lane & 31;
#pragma unroll 1
      for (int ks = 0; ks < 4; ++ks)
#pragma unroll
        for (int hh = 0; hh < 2; ++hh) { float x[8], y[8];
#pragma unroll
            for (int jj = 0; jj < 8; ++jj) { const int jt = 16 * ks + 8 * (jj >> 2) + 4 * hh + (jj & 3); const float tv = Tl[jt * 64 + lane]; x[jj] = tv * btl[jt]; y[jj] = tv * bgl[jt]; }
            *(LAS bf16x8*)(TbF + ((rb * 4 + ks) * 64 + hh * 32 + r) * 16) = PACK8(x, 0); *(LAS bf16x8*)(TbgF + ((rb * 4 + ks) * 64 + hh * 32 + r) * 16) = PACK8(y, 0); } }
    LDS_WAIT(); asm volatile("" ::: "memory");
#pragma unroll 1
    for (int rb = 0; rb < 2; ++rb)
#pragma unroll 1
        for (int cb = 0; cb < 4; ++cb) { f32x16 acc = {};
#pragma unroll
            for (int ks = 0; ks < 4; ++ks) acc = MFMA32(*(const LAS bf16x8*)(TbF + ((rb * 4 + ks) * 64 + lane) * 16), *(const GAS bf16x8*)(VTF + ((size_t)(unit * 4 + cb) * 4 + ks) * 512 + lane * 8), acc);
            bf16* dst = UC + (((size_t)(unit * 2 + rb) * 128 + 32 * cb + c) * 2 + half) * 16;
            *(GAS bf16x8*)dst = PACK8(acc, 0); *(GAS bf16x8*)(dst + 8) = PACK8(acc, 8); }
#pragma unroll 1
    for (int tdk = 0; tdk < 4; ++tdk)
#pragma unroll 1
        for (int rb = 0; rb < 2; ++rb) { f32x16 acc = {};
#pragma unroll
            for (int ks = 0; ks < 4; ++ks) acc = MFMA32(*(const GAS bf16x8*)(KTF + ((size_t)(unit * 4 + tdk) * 4 + ks) * 512 + lane * 8), *(const LAS bf16x8*)(TbgF + ((rb * 4 + ks) * 64 + lane) * 16), acc);
            *(GAS bf16x8*)(WF + ((size_t)(unit * 2 + rb) * 8 + 2 * tdk) * 512 + lane * 8) = PACK8(acc, 0);
            *(GAS bf16x8*)(WF + ((size_t)(unit * 2 + rb) * 8 + 2 * tdk + 1) * 512 + lane * 8) = PACK8(acc, 8); }
    LDS_WAIT(); asm volatile("" ::: "memory");
}

constexpr int SC_BUF = 57344, SC_W = 0, SC_Q = 16384, SC_KT = 32768, SC_QK = 49152, SC_OST = 2 * SC_BUF, OST_LD = 132, SC_GF = SC_OST + 64 * OST_LD * 4, SC_END = SC_GF + 2 * GF_STRIDE * 4;
__device__ __forceinline__ void p_gdn_scan(Frame& F, const Args& A, int bh) {
    const int lane = F.lane, wave = F.wave, c = lane & 31, half = lane >> 5; const int b = bh >> 2, h = bh & 3;
    const bf16* QF = (const bf16*)(F.ws + WS_QF); const bf16* KTF = (const bf16*)(F.ws + WS_KTF); const bf16* WF = (const bf16*)(F.ws + WS_WF); const bf16* UC = (const bf16*)(F.ws + WS_UC); const bf16* QKF = (const bf16*)(F.ws + WS_QKF);
    const float* GF = (const float*)(F.ws + WS_GF); const bf16* GZ = (const bf16*)(F.ws + WS_GZ); bf16* CAT = (bf16*)(F.ws + WS_CAT);
    LAS unsigned char* lds = F.lds; LAS float* Ost = (LAS float*)(lds + SC_OST);
    if (wave >= 4) {
        const int lw = wave - 4; v4u st[14]; v4u sg = {0u, 0u, 0u, 0u};
        const int etok = 16 * lw + (lane >> 2), edv = (lane & 3) * 32;
        float go[32];
#pragma unroll
        for (int i = 0; i < 32; ++i) go[i] = A.in[I_GOUTG][edv + i];
#define SC_LOAD(n_) do { const int un_ = bh * 128 + (n_); _Pragma("unroll") for (int i_ = 0; i_ < 14; ++i_) { const int p_ = lw * 64 + lane + 256 * i_; \
            const bf16* s_ = i_ < 4 ? WF + (size_t)un_ * 8192 + (size_t)p_ * 8 : i_ < 8 ? QF + (size_t)un_ * 8192 + (size_t)(p_ - 1024) * 8 : i_ < 12 ? KTF + (size_t)un_ * 8192 + (size_t)(p_ - 2048) * 8 : QKF + (size_t)un_ * 4096 + (size_t)(p_ - 3072) * 8; \
            st[i_] = *(const GAS v4u*)s_; } if (lw == 0 && lane < 48) sg = *(const GAS v4u*)(GF + (size_t)un_ * GF_STRIDE + lane * 4); } while (0)
#define SC_STORE(n_) do { LAS unsigned char* d_ = lds + ((n_) & 1) * SC_BUF; _Pragma("unroll") for (int i_ = 0; i_ < 14; ++i_) *(LAS v4u*)(d_ + (lw * 64 + lane + 256 * i_) * 16) = st[i_]; \
            if (lw == 0 && lane < 48) *(LAS v4u*)(lds + SC_GF + ((n_) & 1) * GF_STRIDE * 4 + lane * 16) = sg; } while (0)
        SC_LOAD(0); SC_STORE(0); LDS_WAIT();
        __syncthreads();
        SC_LOAD(1);
        for (int n = 0; n < 128; ++n) {
            const size_t row = (size_t)b * SEQ + 64 * n + etok;
            v4u zz[4];
#pragma unroll
            for (int i = 0; i < 4; ++i) zz[i] = *(const GAS v4u*)(GZ + row * 512 + h * 128 + edv + 8 * i);
            __syncthreads();
            if (n + 1 < 128) SC_STORE(n + 1);
            LDS_WAIT();
            __syncthreads();
            if (n + 2 < 128) SC_LOAD(n + 2);
            float o[32]; float ss = 0.f;
#pragma unroll
            for (int i = 0; i < 8; ++i) { const f32x4 v = *(const LAS f32x4*)(Ost + etok * OST_LD + edv + 4 * i); o[4 * i] = v[0]; o[4 * i + 1] = v[1]; o[4 * i + 2] = v[2]; o[4 * i + 3] = v[3]; ss += (v[0] * v[0] + v[1] * v[1]) + (v[2] * v[2] + v[3] * v[3]); }
            ss += SWZ_XOR(ss, 1); ss += SWZ_XOR(ss, 2);
            const float rstd = 1.0f / sqrtf(ss * (1.f / 128) + NORM_EPS);
#pragma unroll
            for (int i = 0; i < 4; ++i) { const unsigned zw[4] = {zz[i].x, zz[i].y, zz[i].z, zz[i].w}; v4u ov; unsigned ow[4];
#pragma unroll
                for (int e = 0; e < 4; ++e) { const float z0 = bflo(zw[e]), z1 = bfhi(zw[e]); const int k = 8 * i + 2 * e; ow[e] = pk2(o[k] * rstd * go[k] * silu2(z0), o[k + 1] * rstd * go[k + 1] * silu2(z1)); }
                ov.x = ow[0]; ov.y = ow[1]; ov.z = ow[2]; ov.w = ow[3];
                *(GAS v4u*)(CAT + row * 1024 + 512 + h * 128 + edv + 8 * i) = ov; }
        }
#undef SC_LOAD
#undef SC_STORE
    } else {
        const int dv = 32 * wave + c;
        f32x16 S[4];
#pragma unroll
        for (int t = 0; t < 4; ++t) S[t] = (f32x16){};
        v4u ur[2][2];
#define SC_ULOAD(n_) do { const bf16* up_ = UC + (((size_t)((bh * 128 + (n_)) * 2) * 128 + dv) * 2 + half) * 16; _Pragma("unroll") for (int rb_ = 0; rb_ < 2; ++rb_) { ur[rb_][0] = *(const GAS v4u*)(up_ + (size_t)rb_ * 128 * 32); ur[rb_][1] = *(const GAS v4u*)(up_ + (size_t)rb_ * 128 * 32 + 8); } } while (0)
        SC_ULOAD(0);
        __syncthreads();
        for (int n = 0; n < 128; ++n) {
            const LAS unsigned char* buf = lds + (n & 1) * SC_BUF; const LAS float* gf = (const LAS float*)(lds + SC_GF + (n & 1) * GF_STRIDE * 4);
            bf16x8 Sb[8];
#pragma unroll
            for (int t = 0; t < 4; ++t) { Sb[2 * t] = PACK8(S[t], 0); Sb[2 * t + 1] = PACK8(S[t], 8); }
            f32x16 o[2], P[2];
#pragma unroll
            for (int rb = 0; rb < 2; ++rb) { o[rb] = (f32x16){}; P[rb] = (f32x16){};
#pragma unroll
                for (int ks = 0; ks < 8; ++ks) { P[rb] = MFMA32(*(const LAS bf16x8*)(buf + SC_W + ((rb * 8 + ks) * 64 + lane) * 16), Sb[ks], P[rb]); o[rb] = MFMA32(*(const LAS bf16x8*)(buf + SC_Q + ((rb * 8 + ks) * 64 + lane) * 16), Sb[ks], o[rb]); } }
            bf16x8 VNb[4], VNd[4];
#pragma unroll
            for (int rb = 0; rb < 2; ++rb) { const unsigned uw[8] = {ur[rb][0].x, ur[rb][0].y, ur[rb][0].z, ur[rb][0].w, ur[rb][1].x, ur[rb][1].y, ur[rb][1].z, ur[rb][1].w}; float vn[16], vd[16];
#pragma unroll
                for (int a = 0; a < 4; ++a) { const f32x4 eg = *(const LAS f32x4*)(gf + 32 * rb + 8 * a + 4 * half), dd = *(const LAS f32x4*)(gf + 64 + 32 * rb + 8 * a + 4 * half);
#pragma unroll
                    for (int e = 0; e < 4; ++e) { const int reg = 4 * a + e; const float u = (reg & 1) ? bfhi(uw[reg >> 1]) : bflo(uw[reg >> 1]); vn[reg] = u - P[rb][reg]; vd[reg] = vn[reg] * dd[e]; o[rb][reg] *= eg[e]; } }
                VNb[2 * rb] = PACK8(vn, 0); VNb[2 * rb + 1] = PACK8(vn, 8); VNd[2 * rb] = PACK8(vd, 0); VNd[2 * rb + 1] = PACK8(vd, 8); }
            if (n + 1 < 128) SC_ULOAD(n + 1);
#pragma unroll
            for (int ks = 0; ks < 2; ++ks) o[0] = MFMA32(*(const LAS bf16x8*)(buf + SC_QK + ((0 * 4 + ks) * 64 + lane) * 16), VNb[ks], o[0]);
#pragma unroll
            for (int ks = 0; ks < 4; ++ks) o[1] = MFMA32(*(const LAS bf16x8*)(buf + SC_QK + ((1 * 4 + ks) * 64 + lane) * 16), VNb[ks], o[1]);
            __syncthreads();
#pragma unroll
            for (int rb = 0; rb < 2; ++rb)
#pragma unroll
                for (int reg = 0; reg < 16; ++reg) Ost[(32 * rb + (reg & 3) + 8 * (reg >> 2) + 4 * half) * OST_LD + dv] = o[rb][reg];
            const float gam = gf[128];
            LDS_WAIT();
#pragma unroll
            for (int t = 0; t < 4; ++t) { S[t] *= gam;
#pragma unroll
                for (int ks = 0; ks < 4; ++ks) S[t] = MFMA32(*(const LAS bf16x8*)(buf + SC_KT + ((t * 4 + ks) * 64 + lane) * 16), VNd[ks], S[t]); }
            __syncthreads();
        }
#undef SC_ULOAD
    }
}

typedef _Float16 f16x8 __attribute__((ext_vector_type(8)));
typedef float f32x4v __attribute__((ext_vector_type(4)));
constexpr int SEL_CAP = 512, SEL_TRIG = SEL_CAP - 16, SEL_WAVE_LDS = 16384;
__device__ __forceinline__ float unsortable(unsigned k) { const unsigned u = (k & 0x80000000u) ? (k & 0x7fffffffu) : ~k; return __builtin_bit_cast(float, u); }
__device__ __forceinline__ unsigned sel_compact(LAS unsigned* ck, LAS unsigned short* ci, int n, int lane) {
    unsigned k[8]; unsigned short id[8];
#pragma unroll
    for (int j = 0; j < 8; ++j) { const int e = j * 64 + lane; k[j] = e < n ? ck[e] : 0u; id[j] = e < n ? ci[e] : (unsigned short)0; }
    unsigned cur = 0u;
#pragma unroll 1
    for (int bit = 31; bit >= 0; --bit) { const unsigned v = cur | (1u << bit); int c = 0;
#pragma unroll
        for (int j = 0; j < 8; ++j) c += (int)__popcll(__ballot(k[j] >= v));
        if (c >= TOPK) cur = v; }
    int cgt = 0;
#pragma unroll
    for (int j = 0; j < 8; ++j) cgt += (int)__popcll(__ballot(k[j] > cur));
    const int need = TOPK - cgt; int outc = 0, eqc = 0; const unsigned long long lt = (1ull << lane) - 1ull;
#pragma unroll
    for (int j = 0; j < 8; ++j) { const bool gt = k[j] > cur, eq = k[j] == cur; const unsigned long long eb = __ballot(eq);
        const bool take = gt || (eq && (eqc + (int)__popcll(eb & lt)) < need); const unsigned long long tb = __ballot(take);
        if (take) { const int pos = outc + (int)__popcll(tb & lt); ck[pos] = k[j]; ci[pos] = id[j]; }
        outc += (int)__popcll(tb); eqc += (int)__popcll(eb); }
    LDS_WAIT(); asm volatile("" ::: "memory");
    return cur;
}
__device__ __forceinline__ void p_dsa_select(Frame& F, int gw0, int ngw) {
    int lane = F.lane; asm volatile("" : "+v"(lane));
    const __half* QIDX = (const __half*)(F.ws + WS_QIDX); const __half* KIDX = (const __half*)(F.ws + WS_KIDX); const float* WIDX = (const float*)(F.ws + WS_WIDX);
    unsigned long long* MASKT = (unsigned long long*)(F.ws + WS_MASK);
    LAS unsigned char* wl = F.lds + F.wave * SEL_WAVE_LDS;
    { unsigned wb_ = (unsigned)(uintptr_t)wl; asm volatile("" : "+v"(wb_)); wl = (LAS unsigned char*)(uintptr_t)wb_; }
    LAS unsigned* CK = (LAS unsigned*)wl;
    LAS unsigned short* CI = (LAS unsigned short*)(wl + 8192);
    LAS unsigned* MR = (LAS unsigned*)(wl + 12288);
    const int col = lane & 15, grp = lane >> 4;
#pragma unroll 1
    for (int gw = gw0; gw < 2048; gw += ngw)
#pragma unroll 1
    for (int half = 0; half < 2; ++half) { const int b = gw >> 10, p = gw & 1023;
        const int u = half ? 2047 - p : p; const int t0 = 4 * u; const size_t m0 = (size_t)b * SEQ + t0;
        f16x8 qa[2];
#pragma unroll
        for (int ks = 0; ks < 2; ++ks) qa[ks] = *(const GAS f16x8*)(QIDX + (m0 + (col >> 2)) * 256 + (col & 3) * 64 + 32 * ks + 8 * grp);
        const f32x4v wq = *(const GAS f32x4v*)(WIDX + (m0 + grp) * 4);
        const int tq = t0 + grp;
        float tau0 = -INFINITY, tau1 = -INFINITY, tau2 = -INFINITY, tau3 = -INFINITY; int c0 = 0, c1 = 0, c2 = 0, c3 = 0;
        const int ntiles = (t0 + 3) / 16 + 1;
        const __half* kbase = KIDX + ((size_t)b * SEQ + col) * 64 + 8 * grp;
        f16x8 cb[4][2], nb[4][2];
#pragma unroll
        for (int i = 0; i < 4; ++i) { const int tl = i < ntiles ? i : ntiles - 1;
#pragma unroll
            for (int ks = 0; ks < 2; ++ks) cb[i][ks] = *(const GAS f16x8*)(kbase + (size_t)tl * 16 * 64 + 32 * ks); }
#pragma unroll 1
        for (int tile = 0; tile < ntiles; tile += 4) {
#pragma unroll
            for (int i = 0; i < 4; ++i) { int tl = tile + 4 + i; tl = tl < ntiles ? tl : ntiles - 1;
#pragma unroll
                for (int ks = 0; ks < 2; ++ks) nb[i][ks] = *(const GAS f16x8*)(kbase + (size_t)tl * 16 * 64 + 32 * ks); }
#pragma unroll
            for (int i = 0; i < 4; ++i) {
                if (tile + i < ntiles) {
                    f32x4v acc = {0.f, 0.f, 0.f, 0.f};
                    acc = __builtin_amdgcn_mfma_f32_16x16x32_f16(qa[0], cb[i][0], acc, 0, 0, 0);
                    acc = __builtin_amdgcn_mfma_f32_16x16x32_f16(qa[1], cb[i][1], acc, 0, 0, 0);
                    const float sc = wq[0] * fmaxf(acc[0], 0.f) + wq[1] * fmaxf(acc[1], 0.f) + wq[2] * fmaxf(acc[2], 0.f) + wq[3] * fmaxf(acc[3], 0.f);
                    const int key = 16 * (tile + i) + col;
                    const float tau = grp == 0 ? tau0 : grp == 1 ? tau1 : grp == 2 ? tau2 : tau3;
                    const bool pass = key <= tq && sc > tau;
                    const unsigned long long bal = __ballot(pass);
                    if (bal) {
                        const unsigned gb = (unsigned)(bal >> (16 * grp)) & 0xffffu; const int cg = grp == 0 ? c0 : grp == 1 ? c1 : grp == 2 ? c2 : c3;
                        if (pass) { const int slot = cg + (int)__popc(gb & ((1u << col) - 1u)); CK[grp * SEL_CAP + slot] = sortable(sc); CI[grp * SEL_CAP + slot] = (unsigned short)key; }
                        c0 += (int)__popc((unsigned)bal & 0xffffu); c1 += (int)__popc((unsigned)(bal >> 16) & 0xffffu); c2 += (int)__popc((unsigned)(bal >> 32) & 0xffffu); c3 += (int)__popc((unsigned)(bal >> 48) & 0xffffu);
                        if (c0 > SEL_TRIG || c1 > SEL_TRIG || c2 > SEL_TRIG || c3 > SEL_TRIG) {
                            LDS_WAIT(); asm volatile("" ::: "memory");
                            if (c0 > SEL_TRIG) { tau0 = unsortable(sel_compact(CK, CI, c0, lane)); c0 = TOPK; }
                            if (c1 > SEL_TRIG) { tau1 = unsortable(sel_compact(CK + SEL_CAP, CI + SEL_CAP, c1, lane)); c1 = TOPK; }
                            if (c2 > SEL_TRIG) { tau2 = unsortable(sel_compact(CK + 2 * SEL_CAP, CI + 2 * SEL_CAP, c2, lane)); c2 = TOPK; }
                            if (c3 > SEL_TRIG) { tau3 = unsortable(sel_compact(CK + 3 * SEL_CAP, CI + 3 * SEL_CAP, c3, lane)); c3 = TOPK; }
                        }
                    }
                }
            }
#pragma unroll
            for (int i = 0; i < 4; ++i)
#pragma unroll
                for (int ks = 0; ks < 2; ++ks) cb[i][ks] = nb[i][ks];
        }
        LDS_WAIT(); asm volatile("" ::: "memory");
        if (c0 > TOPK) { (void)sel_compact(CK, CI, c0, lane); c0 = TOPK; }
        if (c1 > TOPK) { (void)sel_compact(CK + SEL_CAP, CI + SEL_CAP, c1, lane); c1 = TOPK; }
        if (c2 > TOPK) { (void)sel_compact(CK + 2 * SEL_CAP, CI + 2 * SEL_CAP, c2, lane); c2 = TOPK; }
        if (c3 > TOPK) { (void)sel_compact(CK + 3 * SEL_CAP, CI + 3 * SEL_CAP, c3, lane); c3 = TOPK; }
#pragma unroll
        for (int j = 0; j < 16; ++j) MR[j * 64 + lane] = 0u;
        LDS_WAIT(); asm volatile("" ::: "memory");
#pragma unroll
        for (int q = 0; q < 4; ++q) { const int cq = q == 0 ? c0 : q == 1 ? c1 : q == 2 ? c2 : c3;
#pragma unroll
            for (int j = 0; j < 4; ++j) { const int e = j * 64 + lane; if (e < cq) { const unsigned kidx = CI[q * SEL_CAP + e]; __hip_atomic_fetch_or(MR + q * 256 + (kidx >> 5), 1u << (kidx & 31), __ATOMIC_RELAXED, __HIP_MEMORY_SCOPE_WORKGROUP); } } }
        LDS_WAIT(); asm volatile("" ::: "memory");
#pragma unroll
        for (int j = 0; j < 2; ++j) { const int w = lane + 64 * j; v4u a, c;
            a.x = MR[0 * 256 + 2 * w]; a.y = MR[0 * 256 + 2 * w + 1]; a.z = MR[1 * 256 + 2 * w]; a.w = MR[1 * 256 + 2 * w + 1];
            c.x = MR[2 * 256 + 2 * w]; c.y = MR[2 * 256 + 2 * w + 1]; c.z = MR[3 * 256 + 2 * w]; c.w = MR[3 * 256 + 2 * w + 1];
            GAS v4u* dst = (GAS v4u*)(MASKT + ((size_t)(b * 128 + w) * SEQ + t0));
            dst[0] = a; dst[1] = c; }
        LDS_WAIT(); asm volatile("" ::: "memory");
    }
}

#define XB_TMO      128
#define XB_XCNT(j)  (256  + 64 * (j))
#define XB_XSUB(j)  (1280 + 64 * (j))
#define XB_XGEN(j)  (2304 + 64 * (j))
#define XB_TOP      3328
#define XB_TOPGEN   3392
#define XCD_BAR_WORDS 3456
#define XB_SPIN_CAP (1u << 18)

__device__ __forceinline__ unsigned xb_ld(unsigned* p)              { return __hip_atomic_load(p, __ATOMIC_RELAXED, __HIP_MEMORY_SCOPE_AGENT); }
__device__ __forceinline__ unsigned xb_add(unsigned* p, unsigned v) { return __hip_atomic_fetch_add(p, v, __ATOMIC_RELAXED, __HIP_MEMORY_SCOPE_AGENT); }
__device__ __forceinline__ unsigned xb_xcc_id() { return (unsigned)__builtin_amdgcn_s_getreg((3 << 11) | 20) & 0xFu; }
#define XB_SPIN(cond, bar) do { unsigned _sp = 0; while (cond) { __builtin_amdgcn_s_sleep(1); \
    if ((++_sp & 255u) == 0u) { if (xb_ld(&(bar)[XB_TMO])) break; if (_sp > XB_SPIN_CAP) { atomicAdd(&(bar)[XB_TMO], 1u); break; } } } } while (0)

struct XcdBarrier {
    unsigned* bar; unsigned x;
    volatile LAS unsigned* st;
};

__device__ __forceinline__ XcdBarrier xcd_barrier_post(unsigned* bar, volatile LAS unsigned* st) {
    XcdBarrier b; b.bar = bar; b.x = xb_xcc_id(); b.st = st;
    if (threadIdx.x == 0) (void)xb_add(&bar[XB_XCNT(b.x)], 1u);
    return b;
}
__device__ __forceinline__ void xcd_barrier_complete(unsigned* bar, unsigned x, unsigned& nloc, unsigned& nx) {
    const unsigned G = gridDim.x * gridDim.y * gridDim.z;
    unsigned sum, cnt, mine, sp = 0u;
    for (;;) {
        sum = 0u; cnt = 0u; mine = 0u;
#pragma unroll
        for (unsigned j = 0; j < 16; ++j) { const unsigned c = xb_ld(&bar[XB_XCNT(j)]); sum += c; cnt += (c > 0u) ? 1u : 0u; mine = (j == x) ? c : mine; }
        if (sum == G) break;
        __builtin_amdgcn_s_sleep(1);
        if ((++sp & 255u) == 0u) { if (xb_ld(&bar[XB_TMO])) break; if (sp > XB_SPIN_CAP) { atomicAdd(&bar[XB_TMO], 1u); break; } }
    }
    nloc = mine > 0u ? mine : 1u; nx = cnt > 0u ? cnt : 1u;
}

__device__ __forceinline__ void xcd_barrier(const XcdBarrier& b) {
    asm volatile("s_waitcnt vmcnt(0)" ::: "memory");
    __syncthreads();
    if (threadIdx.x == 0) {
        unsigned* bar = b.bar;
        __builtin_amdgcn_s_waitcnt(0);
        unsigned nloc = b.st[0], nx = b.st[1];
        if (nloc == 0u) { xcd_barrier_complete(bar, b.x, nloc, nx); b.st[0] = nloc; b.st[1] = nx; }
        const unsigned old = xb_add(&bar[XB_XSUB(b.x)], 1u);
        const unsigned gen = old / nloc;
        if (old + 1u == (gen + 1u) * nloc) {
            __builtin_amdgcn_fence(__ATOMIC_RELEASE, "agent");
            asm volatile("s_waitcnt vmcnt(0)" ::: "memory");
            const unsigned og = xb_add(&bar[XB_TOP], 1u);
            const unsigned tg = og / nx;
            if (og + 1u == (tg + 1u) * nx) xb_add(&bar[XB_TOPGEN], 1u);
            else XB_SPIN(xb_ld(&bar[XB_TOPGEN]) == tg, bar);
            __builtin_amdgcn_fence(__ATOMIC_ACQUIRE, "agent");
            xb_add(&bar[XB_XGEN(b.x)], 1u);
            asm volatile("s_waitcnt vmcnt(0)" ::: "memory");
        } else {
            XB_SPIN(xb_ld(&bar[XB_XGEN(b.x)]) == gen, bar);
            __builtin_amdgcn_fence(__ATOMIC_ACQUIRE, "agent");
            asm volatile("s_waitcnt vmcnt(0)" ::: "memory");
        }
    }
    __syncthreads();
}
#ifndef XMASK
#define XMASK 0
#endif
enum { PH_PRO = 0, PH_F1A, PH_F1B, PH_ROW1, PH_INPROJ, PH_PREP1, PH_QPROJ, PH_PREP2, PH_MIX, PH_ATT, PH_DBG, PH_OUTPROJ, PH_ROW2, PH_F2A, PH_F2B, PH_ROW3, PH_N };

__global__ void __launch_bounds__(NTHR, 2) mega_fwd(Args args) {
    extern __shared__ __attribute__((aligned(16))) unsigned char lds[];
    Frame F; F.lds = (LAS unsigned char*)lds; F.tid = threadIdx.x; F.lane = F.tid & 63; F.wave = __builtin_amdgcn_readfirstlane(F.tid >> 6); F.G = gridDim.x; F.bid = blockIdx.x; F.ws = args.ws;
    unsigned char* ws = args.ws;
    const int lo = args.ph_lo, hi = args.ph_hi;
#define IN(k) (lo <= (k) && (k) < hi)
#define SEAM(k) do { if (IN(k) && IN((k) + 1)) xcd_barrier(bar); FRESH(); } while (0)
#define FRESH() do { int t_ = threadIdx.x; asm volatile("" : "+v"(t_)); F.tid = t_; F.lane = t_ & 63; \
        F.wave = __builtin_amdgcn_readfirstlane(t_ >> 6); XN = (bf16*)(ws + WS_XN); FB = (bf16*)(ws + WS_FB); HID = (bf16*)(ws + WS_HID); } while (0)
    bf16* XN = (bf16*)(ws + WS_XN); bf16* FB = (bf16*)(ws + WS_FB); bf16* HID = (bf16*)(ws + WS_HID);
    { volatile LAS unsigned* misc = (volatile LAS unsigned*)(F.lds + LDS_MISC_OFF); if (F.tid < 16) misc[F.tid] = 0u; }
    __syncthreads();
    XcdBarrier bar = xcd_barrier_post((unsigned*)(ws + WS_CTL) + CW_BAR, (volatile LAS unsigned*)(F.lds + LDS_MISC_OFF));
    FRESH();
    if (IN(PH_PRO) && !(XMASK >> PH_PRO & 1)) { p_prologue(F, args); } SEAM(PH_PRO);
    if (IN(PH_F1A) && !(XMASK >> PH_F1A & 1)) { pg8::Gemm g{XN, (const bf16*)(ws + WS_WA), TT, 2 * DFF, DM}; pg8::StaticOrder S; S.init(TT, 2 * DFF, F.G, F.bid); pg8::EpiSwiGLU E{HID, DFF};
        pg8::gemm_phase<pg8::EpiSwiGLU, pg8::StaticOrder, true, true>(F.lds, g, S, E); } SEAM(PH_F1A);
    if (IN(PH_F1B) && !(XMASK >> PH_F1B & 1)) { pg8::Gemm g{HID, (const bf16*)(ws + WS_WB), TT, DM, DFF}; pg8::StaticOrder S; S.init(TT, DM, F.G, F.bid); pg8::EpiPlain E{FB, DM};
        pg8::gemm_phase<pg8::EpiPlain, pg8::StaticOrder, true, true>(F.lds, g, S, E); } SEAM(PH_F1B);
    if (IN(PH_ROW1) && !(XMASK >> PH_ROW1 & 1)) { p_rowpass(F, FB, args.in[I_X], args.in[I_F1POST], 0.5f, args.out, args.in[I_MPRE], XN); } SEAM(PH_ROW1);
    if (IN(PH_INPROJ) && !(XMASK >> PH_INPROJ & 1)) { pg8::Gemm g{XN, (const bf16*)(ws + WS_WIN), TT, DINP, DM}; pg8::StaticOrder S; S.init(TT, DINP, F.G, F.bid);
        pg8::EpiInProj E{(bf16*)(ws + WS_CQ), (bf16*)(ws + WS_KATT), (bf16*)(ws + WS_VATT), (bf16*)(ws + WS_GRAW), (bf16*)(ws + WS_GZ), (float*)(ws + WS_SPEC)};
        pg8::gemm_phase<pg8::EpiInProj, pg8::StaticOrder, true, true>(F.lds, g, S, E); } SEAM(PH_INPROJ);
    if (IN(PH_PREP1) && !(XMASK >> PH_PREP1 & 1)) { p_prep1(F, args); } SEAM(PH_PREP1);
    if (IN(PH_QPROJ) && !(XMASK >> PH_QPROJ & 1)) { pg8::Gemm g{(const bf16*)(ws + WS_CQ), (const bf16*)(ws + WS_WQ), TT, 768, 256}; pg8::StaticOrder S; S.init(TT, 768, F.G, F.bid); pg8::EpiPlain E{(bf16*)(ws + WS_QRAW), 768};
        pg8::gemm_phase<pg8::EpiPlain, pg8::StaticOrder, true, true>(F.lds, g, S, E); } SEAM(PH_QPROJ);
    if (IN(PH_PREP2) && !(XMASK >> PH_PREP2 & 1)) { if (F.wave & 1) p_prep2(F, args, F.bid * 4 + (F.wave >> 1), F.G * 4);
        else for (int unit = F.bid * 4 + (F.wave >> 1); unit < 1024; unit += F.G * 4) gdn_pre_unit(F, unit, F.lds + (F.wave >> 1) * 33792); } SEAM(PH_PREP2);
    if (IN(PH_MIX) && !(XMASK >> PH_MIX & 1)) {
#if defined(GDN_NAIVE)
        if (F.bid < 8) p_gdn_naive(F, args, F.bid);
#else
        if (F.bid < 8) p_gdn_scan(F, args, F.bid);
#endif
#if defined(DSA_NAIVE) || defined(DSA_EXP_A)
        else p_dsa_naive(F, args, 8, F.G - 8);
#else
        else p_dsa_select(F, (F.bid - 8) * NWAVES + F.wave, (F.G - 8) * NWAVES);
#endif
    } SEAM(PH_MIX);
    if (IN(PH_ATT) && !(XMASK >> PH_ATT & 1)) {
#if !defined(DSA_NAIVE)
#if defined(DBG_SUBSET)
        const attn_body::AttnTensors AT{(const attn_body::bf16*)(ws + WS_Q), (const attn_body::bf16*)(ws + WS_KATT), (const attn_body::bf16*)(ws + WS_VATT), (attn_body::bf16*)(ws + WS_QF), (const unsigned long long*)(ws + WS_MASK)};
#else
        const attn_body::AttnTensors AT{(const attn_body::bf16*)(ws + WS_Q), (const attn_body::bf16*)(ws + WS_KATT), (const attn_body::bf16*)(ws + WS_VATT), (attn_body::bf16*)(ws + WS_CAT), (const unsigned long long*)(ws + WS_MASK)};
#endif
        const attn_body::StaticOrder S((int)F.G, (int)F.bid);
        attn_body::attn_phase<attn_body::StaticOrder>((char*)lds, AT, S);
#endif
    } SEAM(PH_ATT);
    if (IN(PH_DBG)) {
#if defined(DBG_SUBSET)
        const int gw = F.bid * NWAVES + F.wave, NGW = F.G * NWAVES;
        for (int m = gw; m < TT; m += NGW) { const int b = m >> 13, t = m & (SEQ - 1); (void)b; (void)t;
            if (DBG_SUBSET) { const v4u v = *(const GAS v4u*)((const bf16*)(ws + WS_QF) + (size_t)m * 1024 + F.lane * 8); *(GAS v4u*)((bf16*)(ws + WS_CAT) + (size_t)m * 1024 + F.lane * 8) = v; } }
#endif
    } SEAM(PH_DBG);
    if (IN(PH_OUTPROJ) && !(XMASK >> PH_OUTPROJ & 1)) { pg8::Gemm g{(const bf16*)(ws + WS_CAT), (const bf16*)(ws + WS_WOUT), TT, DM, DM}; pg8::StaticOrder S; S.init(TT, DM, F.G, F.bid); pg8::EpiPlain E{FB, DM};
        pg8::gemm_phase<pg8::EpiPlain, pg8::StaticOrder, true, true>(F.lds, g, S, E); } SEAM(PH_OUTPROJ);
    if (IN(PH_ROW2) && !(XMASK >> PH_ROW2 & 1)) { conv_ffn_weights(F, args, 1); p_rowpass(F, FB, args.out, args.in[I_MPOST], 1.0f, args.out, args.in[I_F2PRE], XN); } SEAM(PH_ROW2);
    if (IN(PH_F2A) && !(XMASK >> PH_F2A & 1)) { pg8::Gemm g{XN, (const bf16*)(ws + WS_WA), TT, 2 * DFF, DM}; pg8::StaticOrder S; S.init(TT, 2 * DFF, F.G, F.bid); pg8::EpiSwiGLU E{HID, DFF};
        pg8::gemm_phase<pg8::EpiSwiGLU, pg8::StaticOrder, true, true>(F.lds, g, S, E); } SEAM(PH_F2A);
    if (IN(PH_F2B) && !(XMASK >> PH_F2B & 1)) { pg8::Gemm g{HID, (const bf16*)(ws + WS_WB), TT, DM, DFF}; pg8::StaticOrder S; S.init(TT, DM, F.G, F.bid); pg8::EpiPlain E{FB, DM};
        pg8::gemm_phase<pg8::EpiPlain, pg8::StaticOrder, true, true>(F.lds, g, S, E); } SEAM(PH_F2B);
    if (IN(PH_ROW3) && !(XMASK >> PH_ROW3 & 1)) { p_rowpass(F, FB, args.out, args.in[I_F2POST], 0.5f, args.out, nullptr, nullptr); }
#undef IN
#undef SEAM
}

extern "C" void kernel_launch(void* const* d_in, const int* in_sizes, int n_in, void* d_out, int out_size, void* d_ws, size_t ws_size, hipStream_t stream) {
    static int grid = 0;
    if (grid == 0) {
        if (n_in != 24 || out_size != TT * DM || ws_size < WS_END) { fprintf(stderr, "kernel_launch: unexpected shapes (n_in %d out %d ws %zu)\n", n_in, out_size, ws_size); grid = -1; return; }
        int dev = 0, cus = 0, per_cu = 0;
        hipGetDevice(&dev); hipDeviceGetAttribute(&cus, hipDeviceAttributeMultiprocessorCount, dev);
        if (hipFuncSetAttribute((const void*)mega_fwd, hipFuncAttributeMaxDynamicSharedMemorySize, LDS_BYTES) != hipSuccess) { fprintf(stderr, "kernel_launch: hipFuncSetAttribute failed\n"); grid = -1; return; }
        if (hipOccupancyMaxActiveBlocksPerMultiprocessor(&per_cu, (const void*)mega_fwd, NTHR, LDS_BYTES) != hipSuccess || per_cu < 1) { fprintf(stderr, "kernel_launch: occupancy query says %d\n", per_cu); per_cu = 1; }
        (void)hipGetLastError();
        grid = cus * (per_cu < 1 ? 1 : 1);
        fprintf(stderr, "kernel_launch: cus %d per_cu %d grid %d\n", cus, per_cu, grid);
    }
    if (grid < 0) return;
    Args a{};
    for (int i = 0; i < 24; ++i) a.in[i] = (const float*)d_in[i];
    a.out = (float*)d_out; a.ws = (unsigned char*)d_ws;
    for (int i = 0; i < 32; ++i) a.invf_att[i] = 1.0f / powf(10000.0f, (float)i / 32.0f);
    for (int i = 0; i < 16; ++i) a.invf_idx[i] = 1.0f / powf(10000.0f, (float)i / 16.0f);
    a.ph_lo = 0; a.ph_hi = PH_N;
    if (hipMemsetAsync((char*)d_ws + WS_CTL, 0, CTL_ZERO_BYTES, stream) != hipSuccess) { fprintf(stderr, "kernel_launch: memset failed\n"); return; }
    void* kargs[] = {&a};
    hipError_t e = hipLaunchCooperativeKernel((const void*)mega_fwd, dim3(grid), dim3(NTHR), kargs, LDS_BYTES, stream);
    if (e != hipSuccess) fprintf(stderr, "kernel_launch: cooperative launch failed: %s (grid %d)\n", hipGetErrorString(e), grid);
}
```

```cpp
#include <hip/hip_runtime.h>
#include <hip/hip_bf16.h>
#include <hip/hip_fp16.h>
#include <cstdio>
#include <cstdint>
#include <cmath>
namespace pg8 {
#define PG8_LAS __attribute__((address_space(3)))
typedef unsigned short bf16_t;
typedef short bf16x8 __attribute__((ext_vector_type(8)));
typedef float f32x4 __attribute__((ext_vector_type(4)));
typedef unsigned u32x4 __attribute__((ext_vector_type(4)));
constexpr int BM = 256, BK = 64, HALF = 128, HTB = HALF * BK * 2  , STAGE_BYTES = 8 * HTB, NXCD = 8, WGM = 8;

__host__ __device__ __forceinline__ int lds_byte(int r, int c) { const int st = (r >> 4) * 2 + (c >> 5), rr = r & 15, cc = c & 31, ob = rr * 64 + cc * 2; return st * 1024 + (ob ^ (((ob >> 9) & 1) << 5)); }
__host__ __device__ __forceinline__ void stage_rc(int b, int& R, int& C) { const int st = b / 1024, sb = b % 1024, swz = sb ^ (((sb >> 9) & 1) << 5); R = (st >> 1) * 16 + swz / 64; C = (st & 1) * 32 + (swz % 64) / 2; }
__host__ __device__ __forceinline__ int perm32(int rho) { const int n = rho >> 4, i = rho & 15; return 8 * (i >> 2) + 4 * n + (i & 3); }

struct Unit { int pm, pn; };
struct Gemm { const bf16_t* A; const bf16_t* Bt; int M, N, K; };

struct StaticOrder {
    int nM, nN, nwg, G, c;
    __host__ __device__ void init(int M, int N, int G_, int c_) { nM = M / BM; nN = N / BM; nwg = nM * nN; G = G_; c = c_; }
    __host__ __device__ bool next(int i, Unit& u) const {
        const long L = (long)i * G + c; if (L >= nwg) return false;
        int wgid = (int)L; { const int q = nwg / NXCD, r = nwg % NXCD, xcd = wgid % NXCD, off = wgid / NXCD; wgid = (xcd < r ? xcd * (q + 1) : r * (q + 1) + (xcd - r) * q) + off; }
        const int nig = WGM * nN, gid = wgid / nig, fm = gid * WGM, gsz = (nM - fm) < WGM ? (nM - fm) : WGM;
        u.pm = fm + ((wgid % nig) % gsz); u.pn = (wgid % nig) / gsz; return true;
    }
    __device__ __forceinline__ void a_ready(const Unit&) const {}
    __device__ __forceinline__ void done(const Unit&) const {}
};

__device__ __forceinline__ unsigned cvt_pk_bf16(float lo, float hi) { unsigned r; asm volatile("v_cvt_pk_bf16_f32 %0, %1, %2" : "=v"(r) : "v"(lo), "v"(hi)); return r; }
typedef float f32x2 __attribute__((ext_vector_type(2)));
__device__ __forceinline__ u32x4 pack8(const f32x4 v0, const f32x4 v1) { u32x4 w; w.x = cvt_pk_bf16(v0[0], v0[1]); w.y = cvt_pk_bf16(v0[2], v0[3]); w.z = cvt_pk_bf16(v1[0], v1[1]); w.w = cvt_pk_bf16(v1[2], v1[3]); return w; }
struct EpiPlain {
    static constexpr bool PERM = true, AFTER_DRAIN = false;
    bf16_t* O; int ldc;
    __device__ __forceinline__ void operator()(const f32x4 (&acc)[2][2][4][2], const Unit& u, int wr, int wc, int fr, int fq) const {
        const int row0 = u.pm * BM + wr * 64 + fr, col0 = u.pn * BM + wc * 32 + 8 * fq;
#pragma unroll
        for (int ai = 0; ai < 2; ++ai)
#pragma unroll
            for (int m = 0; m < 4; ++m) { bf16_t* rowp = O + (size_t)(row0 + ai * HALF + m * 16) * ldc + col0;
#pragma unroll
                for (int bj = 0; bj < 2; ++bj) *(u32x4*)(rowp + bj * HALF) = pack8(acc[ai][bj][m][0], acc[ai][bj][m][1]); }
    }
};
__device__ __forceinline__ float silu_f(float g) { return g * __builtin_amdgcn_rcpf(1.0f + __builtin_amdgcn_exp2f(-1.4426950408889634f * g)); }
struct EpiSwiGLU {
    static constexpr bool PERM = true, AFTER_DRAIN = false;
    bf16_t* H; int ldh;
    __device__ __forceinline__ void operator()(const f32x4 (&acc)[2][2][4][2], const Unit& u, int wr, int wc, int fr, int fq) const {
        const int row0 = u.pm * BM + wr * 64 + fr, col0 = u.pn * HALF + wc * 32 + 8 * fq;
#pragma unroll
        for (int ai = 0; ai < 2; ++ai)
#pragma unroll
            for (int m = 0; m < 4; ++m) { bf16_t* rowp = H + (size_t)(row0 + ai * HALF + m * 16) * ldh + col0;
                f32x4 h0, h1;
#pragma unroll
                for (int i = 0; i < 4; ++i) { h0[i] = silu_f(acc[ai][0][m][0][i]) * acc[ai][1][m][0][i]; h1[i] = silu_f(acc[ai][0][m][1][i]) * acc[ai][1][m][1][i]; }
                *(u32x4*)rowp = pack8(h0, h1); }
    }
};
struct EpiInProj {
    static constexpr bool PERM = true, AFTER_DRAIN = false;
    bf16_t *CQ, *KATT, *VATT, *GRAW, *GZ; float* SPEC;
    __device__ __forceinline__ void operator()(const f32x4 (&acc)[2][2][4][2], const Unit& u, int wr, int wc, int fr, int fq) const {
        const int row0 = u.pm * BM + wr * 64 + fr; const int pn = u.pn;
        if (pn == 13) {
            const int col0 = wc * 32 + 8 * fq;
#pragma unroll
            for (int ai = 0; ai < 2; ++ai)
#pragma unroll
                for (int m = 0; m < 4; ++m) { float* rowp = SPEC + (size_t)(row0 + ai * HALF + m * 16) * 128 + col0;
                    *(f32x4*)rowp = acc[ai][0][m][0]; *(f32x4*)(rowp + 4) = acc[ai][0][m][1]; }
            return;
        }
        bf16_t* base; int ldc, ct;
        if (pn == 0) { base = CQ; ldc = 256; ct = 0; }
        else if (pn < 3) { base = KATT; ldc = 512; ct = (pn - 1) * 256; }
        else if (pn < 5) { base = VATT; ldc = 512; ct = (pn - 3) * 256; }
        else if (pn < 11) { base = GRAW; ldc = 1536; ct = (pn - 5) * 256; }
        else { base = GZ; ldc = 512; ct = (pn - 11) * 256; }
        const int col0 = ct + wc * 32 + 8 * fq;
#pragma unroll
        for (int ai = 0; ai < 2; ++ai)
#pragma unroll
            for (int m = 0; m < 4; ++m) { bf16_t* rowp = base + (size_t)(row0 + ai * HALF + m * 16) * ldc + col0;
#pragma unroll
                for (int bj = 0; bj < 2; ++bj) *(u32x4*)(rowp + bj * HALF) = pack8(acc[ai][bj][m][0], acc[ai][bj][m][1]); }
    }
};
struct EpiQ {
    static constexpr bool PERM = true, AFTER_DRAIN = false;
    bf16_t *QQ, *QI;
    __device__ __forceinline__ void operator()(const f32x4 (&acc)[2][2][4][2], const Unit& u, int wr, int wc, int fr, int fq) const {
        const int row0 = u.pm * BM + wr * 64 + fr; bf16_t* base = u.pn < 2 ? QQ : QI; const int ldc = u.pn < 2 ? 512 : 256; const int col0 = (u.pn < 2 ? u.pn * BM : 0) + wc * 32 + 8 * fq;
#pragma unroll
        for (int ai = 0; ai < 2; ++ai)
#pragma unroll
            for (int m = 0; m < 4; ++m) { bf16_t* rowp = base + (size_t)(row0 + ai * HALF + m * 16) * ldc + col0;
#pragma unroll
                for (int bj = 0; bj < 2; ++bj) *(u32x4*)(rowp + bj * HALF) = pack8(acc[ai][bj][m][0], acc[ai][bj][m][1]); }
    }
};
template <class Epi, class Sched, bool ALIGN_EPI = false, bool SP2 = false>
__device__ __forceinline__ void gemm_phase(PG8_LAS unsigned char* lds, const Gemm g, const Sched& S, const Epi& E) {
    int tid_ = threadIdx.x; asm volatile("" : "+v"(tid_));
    const int tid = tid_, wid = __builtin_amdgcn_readfirstlane(tid >> 6), lane = tid & 63, wr = wid >> 2, wc = wid & 3, fr = lane & 15, fq = lane >> 4;
    const int K = g.K, nt = K / BK;
    unsigned voffA[2], voffB[2];
#pragma unroll
    for (int i = 0; i < 2; ++i) { int R, C; stage_rc(tid * 16 + i * 8192, R, C); const int Rb = Epi::PERM ? ((R & ~31) + perm32(R & 31)) : R;
        voffA[i] = (unsigned)(R * K + C) * 2u; voffB[i] = (unsigned)(Rb * K + C) * 2u; }
    const size_t kstep = (size_t)(BK * 2);
    const size_t hstep = (size_t)HALF * K * 2;
    const size_t tstep = 2 * hstep;
    const unsigned ldsw = (unsigned)wid * 1024u;
    const int aoff = lds_byte(wr * 64 + fr, fq * 8), boff = lds_byte(wc * 32 + fr, fq * 8);
#define PG8_SA(b, h) (((b) * 2 + (h)) * HTB)
#define PG8_SB(b, h) ((4 + (b) * 2 + (h)) * HTB)
#define PG8_STAGE(bufoff, gbase, voff) do { _Pragma("unroll") for (int _i = 0; _i < 2; ++_i) \
        __builtin_amdgcn_global_load_lds((const unsigned*)((const char*)(gbase) + (voff)[_i]), (PG8_LAS unsigned*)(lds + (bufoff) + ldsw + _i * 8192), 16, 0, 0); } while (0)
#define PG8_LDA(dst, b, h) do { _Pragma("unroll") for (int m = 0; m < 4; ++m) _Pragma("unroll") for (int k = 0; k < 2; ++k) dst[m][k] = *(const PG8_LAS bf16x8*)(lds + PG8_SA(b, h) + aoff + m * 2048 + k * 1024); } while (0)
#define PG8_LDB(dst, b, h) do { _Pragma("unroll") for (int n = 0; n < 2; ++n) _Pragma("unroll") for (int k = 0; k < 2; ++k) dst[n][k] = *(const PG8_LAS bf16x8*)(lds + PG8_SB(b, h) + boff + n * 2048 + k * 1024); } while (0)
#define PG8_MMA(ai, bj, At, Bt) do { __builtin_amdgcn_s_setprio(1); _Pragma("unroll") for (int m = 0; m < 4; ++m) _Pragma("unroll") for (int n = 0; n < 2; ++n) _Pragma("unroll") for (int k = 0; k < 2; ++k) \
        acc[ai][bj][m][n] = __builtin_amdgcn_mfma_f32_16x16x32_bf16(Bt[n][k], At[m][k], acc[ai][bj][m][n], 0, 0, 0); __builtin_amdgcn_s_setprio(0); } while (0)
#define PG8_WAIT_V(n) asm volatile("s_waitcnt vmcnt(" #n ")" ::: "memory")
#define PG8_WAIT_L(n) asm volatile("s_waitcnt lgkmcnt(" #n ")" ::: "memory")
#define PG8_BAR __builtin_amdgcn_s_barrier()
#define PG8_SCHED __builtin_amdgcn_sched_barrier(0)
    Unit cur, nxt; int ui = 0;
    if (!S.next(0, cur)) return;
    f32x4 acc[2][2][4][2];
#pragma unroll
    for (int a = 0; a < 2; ++a)
#pragma unroll
        for (int b = 0; b < 2; ++b)
#pragma unroll
            for (int m = 0; m < 4; ++m)
#pragma unroll
                for (int n = 0; n < 2; ++n) acc[a][b][m][n] = (f32x4){0.f, 0.f, 0.f, 0.f};
    bf16x8 At[4][2], B0[2][2], B1[2][2];
    const char* cA = (const char*)g.A + (size_t)cur.pm * tstep; const char* cB = (const char*)g.Bt + (size_t)cur.pn * tstep;
    S.a_ready(cur);
    if constexpr (SP2) {
        PG8_STAGE(PG8_SB(0, 0), cB, voffB); PG8_STAGE(PG8_SB(0, 1), cB + hstep, voffB); PG8_STAGE(PG8_SA(0, 0), cA, voffA); PG8_STAGE(PG8_SA(0, 1), cA + hstep, voffA);
        if (wr == 1) PG8_BAR;
        PG8_WAIT_V(2); PG8_BAR;
        PG8_STAGE(PG8_SB(1, 0), cB + kstep, voffB); PG8_STAGE(PG8_SA(1, 0), cA + kstep, voffA); PG8_STAGE(PG8_SB(1, 1), cB + hstep + kstep, voffB);
        PG8_WAIT_V(6); PG8_BAR;
    } else {
        PG8_STAGE(PG8_SB(0, 0), cB, voffB); PG8_STAGE(PG8_SA(0, 0), cA, voffA); PG8_STAGE(PG8_SB(0, 1), cB + hstep, voffB); PG8_STAGE(PG8_SA(0, 1), cA + hstep, voffA);
        if (wr == 1) PG8_BAR;
        PG8_WAIT_V(4); PG8_BAR;
        PG8_STAGE(PG8_SB(1, 0), cB + kstep, voffB); PG8_STAGE(PG8_SA(1, 0), cA + kstep, voffA); PG8_STAGE(PG8_SB(1, 1), cB + hstep + kstep, voffB);
        PG8_WAIT_V(6); PG8_BAR;
    }
    for (;;) {
        const bool has_next = S.next(ui + 1, nxt);
        const char* nA = has_next ? (const char*)g.A + (size_t)nxt.pm * tstep : cA; const char* nB = has_next ? (const char*)g.Bt + (size_t)nxt.pn * tstep : cB;
        for (int t = 0; t < nt; t += 2) {
            const bool last = (t == nt - 2);
            const char* a1 = cA + (size_t)(t + 1) * kstep;
            const char* a2 = last ? nA : cA + (size_t)(t + 2) * kstep; const char* b2 = last ? nB : cB + (size_t)(t + 2) * kstep;
            const char* a3 = a2 + kstep; const char* b3 = b2 + kstep;
            if (last && has_next) S.a_ready(nxt);
            if constexpr (SP2) {
            PG8_LDB(B0, 0, 0); PG8_LDB(B1, 0, 1); PG8_SCHED; PG8_LDA(At, 0, 0); PG8_STAGE(PG8_SA(1, 1), a1 + hstep, voffA);
            PG8_WAIT_V(8); PG8_WAIT_L(0); PG8_BAR; PG8_MMA(0, 0, At, B0); PG8_MMA(0, 1, At, B1); PG8_BAR; PG8_SCHED;
            PG8_LDA(At, 0, 1); PG8_STAGE(PG8_SB(0, 0), b2, voffB); PG8_STAGE(PG8_SB(0, 1), b2 + hstep, voffB); PG8_STAGE(PG8_SA(0, 0), a2, voffA);
            PG8_WAIT_V(8); PG8_WAIT_L(0); PG8_BAR; PG8_MMA(1, 0, At, B0); PG8_MMA(1, 1, At, B1); PG8_BAR; PG8_SCHED;
            PG8_LDB(B0, 1, 0); PG8_LDB(B1, 1, 1); PG8_SCHED; PG8_LDA(At, 1, 0); PG8_STAGE(PG8_SA(0, 1), a2 + hstep, voffA);
            PG8_WAIT_V(8); PG8_WAIT_L(0); PG8_BAR; PG8_MMA(0, 0, At, B0); PG8_MMA(0, 1, At, B1); PG8_BAR; PG8_SCHED;
            PG8_LDA(At, 1, 1); PG8_STAGE(PG8_SB(1, 0), b3, voffB); PG8_STAGE(PG8_SB(1, 1), b3 + hstep, voffB); PG8_STAGE(PG8_SA(1, 0), a3, voffA);
            PG8_WAIT_V(8); PG8_WAIT_L(0); PG8_BAR; PG8_MMA(1, 0, At, B0); PG8_MMA(1, 1, At, B1); PG8_BAR; PG8_SCHED;
            } else {
            PG8_LDB(B0, 0, 0); PG8_SCHED; PG8_LDA(At, 0, 0); PG8_STAGE(PG8_SA(1, 1), a1 + hstep, voffA);
            PG8_WAIT_L(8); PG8_BAR; PG8_WAIT_L(0); PG8_MMA(0, 0, At, B0); PG8_BAR; PG8_SCHED;
            PG8_LDB(B1, 0, 1); PG8_STAGE(PG8_SB(0, 0), b2, voffB);
            PG8_BAR; PG8_WAIT_L(0); PG8_MMA(0, 1, At, B1); PG8_BAR;
            PG8_LDA(At, 0, 1); PG8_STAGE(PG8_SA(0, 0), a2, voffA);
            PG8_BAR; PG8_WAIT_L(0); PG8_MMA(1, 0, At, B0); PG8_BAR; PG8_SCHED;
            PG8_STAGE(PG8_SB(0, 1), b2 + hstep, voffB);
            PG8_WAIT_V(6); PG8_BAR; PG8_MMA(1, 1, At, B1); PG8_BAR;
            PG8_LDB(B0, 1, 0); PG8_SCHED; PG8_LDA(At, 1, 0); PG8_STAGE(PG8_SA(0, 1), a2 + hstep, voffA);
            PG8_WAIT_L(8); PG8_BAR; PG8_WAIT_L(0); PG8_MMA(0, 0, At, B0); PG8_BAR; PG8_SCHED;
            PG8_LDB(B1, 1, 1); PG8_STAGE(PG8_SB(1, 0), b3, voffB);
            PG8_BAR; PG8_WAIT_L(0); PG8_MMA(0, 1, At, B1); PG8_BAR;
            PG8_LDA(At, 1, 1); PG8_STAGE(PG8_SA(1, 0), a3, voffA);
            PG8_BAR; PG8_WAIT_L(0); PG8_MMA(1, 0, At, B0); PG8_BAR; PG8_SCHED;
            PG8_STAGE(PG8_SB(1, 1), b3 + hstep, voffB);
            PG8_WAIT_V(6); PG8_BAR; PG8_MMA(1, 1, At, B1); PG8_BAR;
            }
        }
        if constexpr (ALIGN_EPI) { if (wr == 0) PG8_BAR; }
        if constexpr (!Epi::AFTER_DRAIN) { E(acc, cur, wr, wc, fr, fq); S.done(cur); }
        if (!has_next) break;
#pragma unroll
        for (int a = 0; a < 2; ++a)
#pragma unroll
            for (int b = 0; b < 2; ++b)
#pragma unroll
                for (int m = 0; m < 4; ++m)
#pragma unroll
                    for (int n = 0; n < 2; ++n) acc[a][b][m][n] = (f32x4){0.f, 0.f, 0.f, 0.f};
        cur = nxt; cA = nA; cB = nB; ++ui;
        if constexpr (ALIGN_EPI) { if (wr == 1) PG8_BAR; }
    }
    PG8_WAIT_V(0);
    if constexpr (!ALIGN_EPI) { if (wr == 0) PG8_BAR; }
    PG8_BAR;
    if constexpr (Epi::AFTER_DRAIN) { E.fused(acc, cur, wr, wc, fr, fq, lds, wid, lane); S.done(cur); }
#undef PG8_SA
#undef PG8_SB
#undef PG8_STAGE
#undef PG8_LDA
#undef PG8_LDB
#undef PG8_MMA
#undef PG8_WAIT_V
#undef PG8_WAIT_L
#undef PG8_BAR
#undef PG8_SCHED
}
}
namespace attn_body {
using bf16=__hip_bfloat16;
using bf16x8=__attribute__((ext_vector_type(8)))short;
using s16x4=__attribute__((ext_vector_type(4)))short;
using f32x16=__attribute__((ext_vector_type(16)))float;
using u32x4=__attribute__((ext_vector_type(4)))unsigned;
constexpr int BATCH=2,NHEAD=8,SEQ=8192,D=64,DM=NHEAD*D,OPITCH=1024;
constexpr int NW=8,QBLK=32,QB=QBLK*NW,KVBLK=64,NQB=SEQ/QB;
constexpr int ATTN_PITCH=DM, ATTN_UNIT_ROWS=QB;
__device__ __forceinline__ int crow(int r,int hi){return (r&3)+8*(r>>2)+4*hi;}
#define SBAR() __builtin_amdgcn_sched_barrier(0)
__device__ __forceinline__ void cmask(f32x16&p0,f32x16&p1,int jb,int qrel,int hi){
  const float NEG=-INFINITY; int kb=64*jb+4*hi;
  #pragma unroll
  for(int r=0;r<16;++r){int kv=kb+(r&3)+8*(r>>2); if(kv>qrel)p0[r]=NEG; if(kv+32>qrel)p1[r]=NEG;}
}

constexpr int NSLOT=3, SLOTB=8192;
constexpr int LDS_K=0, LDS_V=NSLOT*SLOTB, LDS_WS=2*NSLOT*SLOTB, LDS_OST=LDS_WS+NW*64*4, LDS_MK=LDS_OST+NW*4096, MSLOTB=2048, LDS_BYTES=LDS_MK+NSLOT*MSLOTB;
constexpr float C2=0.125f*1.4426950408889634f;
__device__ __forceinline__ void glds16(const void*gsrc,unsigned lds_dst){unsigned keep;
  asm volatile("s_mov_b32 %0, m0\n\ts_mov_b32 m0, %2\n\ts_nop 0\n\tglobal_load_lds_dwordx4 %1, off\n\ts_mov_b32 m0, %0":"=&s"(keep):"v"(gsrc),"s"(lds_dst):"memory");}
__device__ __forceinline__ void glds16s(unsigned voff,const void*sbase,unsigned lds_dst){unsigned keep;
  asm volatile("s_mov_b32 %0, m0\n\ts_mov_b32 m0, %3\n\ts_nop 0\n\tglobal_load_lds_dwordx4 %1, %2\n\ts_mov_b32 m0, %0":"=&s"(keep):"v"(voff),"s"(sbase),"s"(lds_dst):"memory");}
__device__ __forceinline__ float fand_bits(float x,int m){return __builtin_bit_cast(float,__builtin_bit_cast(int,x)&m);}
__device__ __forceinline__ float max3f(float a,float b,float c){float r;asm("v_max3_f32 %0, %1, %2, %3":"=v"(r):"v"(a),"v"(b),"v"(c));return r;}
__device__ __forceinline__ float max2f(float a,float b){float r;asm("v_max_f32_e32 %0, %1, %2":"=v"(r):"v"(a),"v"(b));return r;}
__device__ __forceinline__ float fadd_s(float a,float b){float r;asm("v_add_f32_e32 %0, %1, %2":"=v"(r):"v"(a),"v"(b));return r;}
__device__ __forceinline__ float fsub_s(float a,float b){float r;asm("v_sub_f32_e32 %0, %1, %2":"=v"(r):"v"(a),"v"(b));return r;}
typedef float f32x2_t __attribute__((ext_vector_type(2))); typedef __bf16 bf16x2_t __attribute__((ext_vector_type(2)));
__device__ __forceinline__ unsigned cvtpk_s(float lo,float hi){f32x2_t v={lo,hi};bf16x2_t b=__builtin_convertvector(v,bf16x2_t);return __builtin_bit_cast(unsigned,b);}
#define WAIT_BAR(N) asm volatile("s_waitcnt vmcnt(" #N ") lgkmcnt(0)\n\ts_barrier":::"memory")

__device__ __forceinline__ void qkt(f32x16&p0,f32x16&p1,const char*Kslot,const bf16x8*qr,const f32x16&negm,int r32,int hi){
  const char*kb=Kslot+hi*1024+r32*16;
  #pragma unroll
  for(int d0=0;d0<4;++d0){
    const bf16x8 b0=*reinterpret_cast<const bf16x8*>(kb+d0*2048);
    const bf16x8 b1=*reinterpret_cast<const bf16x8*>(kb+d0*2048+512);
    if(d0==0){p0=__builtin_amdgcn_mfma_f32_32x32x16_bf16(b0,qr[0],negm,0,0,0);p1=__builtin_amdgcn_mfma_f32_32x32x16_bf16(b1,qr[0],negm,0,0,0);}
    else{p0=__builtin_amdgcn_mfma_f32_32x32x16_bf16(b0,qr[d0],p0,0,0,0);p1=__builtin_amdgcn_mfma_f32_32x32x16_bf16(b1,qr[d0],p1,0,0,0);}}
}
typedef __attribute__((address_space(3))) const char* lds_cptr;
typedef short v4i16_t __attribute__((ext_vector_type(4)));
__device__ __forceinline__ void kload8(bf16x8*kf,lds_cptr kp){
  kf[0]=*(const __attribute__((address_space(3))) bf16x8*)(kp);      kf[1]=*(const __attribute__((address_space(3))) bf16x8*)(kp+512);
  kf[2]=*(const __attribute__((address_space(3))) bf16x8*)(kp+2048); kf[3]=*(const __attribute__((address_space(3))) bf16x8*)(kp+2560);
  kf[4]=*(const __attribute__((address_space(3))) bf16x8*)(kp+4096); kf[5]=*(const __attribute__((address_space(3))) bf16x8*)(kp+4608);
  kf[6]=*(const __attribute__((address_space(3))) bf16x8*)(kp+6144); kf[7]=*(const __attribute__((address_space(3))) bf16x8*)(kp+6656);
}
__device__ __forceinline__ void kload2(bf16x8*kf,lds_cptr kp,int j){ kf[2*j]=*(const __attribute__((address_space(3))) bf16x8*)(kp+j*2048); kf[2*j+1]=*(const __attribute__((address_space(3))) bf16x8*)(kp+j*2048+512); }
__device__ __forceinline__ s16x4 vtr(lds_cptr p){ return __builtin_bit_cast(s16x4,__builtin_amdgcn_ds_read_tr16_b64_v4i16((__attribute__((address_space(3))) v4i16_t*)p)); }
__device__ __forceinline__ float rowmax(const f32x16&p0,const f32x16&p1){
  float a=max3f(p0[0],p0[1],p1[0]),b=max3f(p0[2],p0[3],p1[1]);a=max3f(a,p1[2],p1[3]);
  #pragma unroll
  for(int r=4;r<16;r+=4){a=max3f(a,p0[r],p0[r+1]);b=max3f(b,p0[r+2],p0[r+3]);a=max3f(a,p1[r],p1[r+1]);b=max3f(b,p1[r+2],p1[r+3]);}
  const float m=max2f(a,b);
  auto rr=__builtin_amdgcn_permlane32_swap(__float_as_uint(m),__float_as_uint(m),false,false);
  return max2f(__uint_as_float(rr[0]),__uint_as_float(rr[1]));
}
__device__ __forceinline__ void pv(f32x16*o,int vb,bf16x8 pa0,bf16x8 pa1,bf16x8 pa2,bf16x8 pa3){
  #pragma unroll
  for(int d0=0;d0<2;++d0){s16x4 lo[4],hi[4];
    #pragma unroll
    for(int ks=0;ks<4;++ks){
      asm volatile("ds_read_b64_tr_b16 %0,%1 offset:%c2":"=&v"(lo[ks]):"v"(vb),"i"(d0*4096+ks*1024):"memory");
      asm volatile("ds_read_b64_tr_b16 %0,%1 offset:%c2":"=&v"(hi[ks]):"v"(vb),"i"(d0*4096+ks*1024+512):"memory");}
    asm volatile("s_waitcnt lgkmcnt(0)":::"memory");SBAR();
    #define PK(k) (bf16x8){lo[k][0],lo[k][1],lo[k][2],lo[k][3],hi[k][0],hi[k][1],hi[k][2],hi[k][3]}
    o[d0]=__builtin_amdgcn_mfma_f32_32x32x16_bf16(pa0,PK(0),o[d0],0,0,0);
    o[d0]=__builtin_amdgcn_mfma_f32_32x32x16_bf16(pa1,PK(1),o[d0],0,0,0);
    o[d0]=__builtin_amdgcn_mfma_f32_32x32x16_bf16(pa2,PK(2),o[d0],0,0,0);
    o[d0]=__builtin_amdgcn_mfma_f32_32x32x16_bf16(pa3,PK(3),o[d0],0,0,0);
    #undef PK
  }
}

#ifndef ATTN_STORE16
#define ATTN_STORE16(p,v) (*(u32x4*)(p)=(v))
#endif
template<int THRL> __device__ __forceinline__ void attn_unit(int b,int h,int qb,const bf16*Q,const bf16*__restrict__ K,const bf16*__restrict__ V,bf16*O,const unsigned long long*__restrict__ MK,char*shm){
  int tid_=threadIdx.x; asm volatile("":"+v"(tid_)); const int tid=tid_,lane=tid&63,r32=lane&31,hi=lane>>5; const int wid=__builtin_amdgcn_readfirstlane(tid>>6);
  const long rowbase=(long)b*SEQ; const int q0=qb*QB;
  const bf16*Qw=Q+(rowbase+q0+wid*QBLK)*DM+h*D;
  const bf16*Kh=K+rowbase*DM+h*D,*Vh=V+rowbase*DM+h*D;
  const unsigned lds0=(unsigned)(uintptr_t)shm;
  float*wsf=(float*)(shm+LDS_WS)+wid*64;
  const bf16*ksrc=Kh+(long)lane*DM+wid*8;
  const bf16*vsrc=Vh+(long)(16*(wid&3)+(lane>>2))*DM+(wid>>2)*32+(lane&3)*8;
  const unsigned kdst=lds0+LDS_K+wid*1024, vdst=lds0+LDS_V+wid*1024;
  #define DMA_K(t,slot) glds16(ksrc+(long)(t)*KVBLK*DM,(unsigned)__builtin_amdgcn_readfirstlane(kdst+(slot)))
  #define DMA_V(t,slot) glds16(vsrc+(long)(t)*KVBLK*DM,(unsigned)__builtin_amdgcn_readfirstlane(vdst+(slot)))
  const unsigned long long*msrc=MK+((long)b*128)*SEQ+q0+wid*QBLK;
  const unsigned mdst=lds0+LDS_MK+wid*256;
  #define DMA_M(t,mslot) do{ if(lane<16) glds16s((unsigned)lane*16u,msrc+(long)(t)*SEQ,(unsigned)__builtin_amdgcn_readfirstlane(mdst+(mslot))); }while(0)
  #define MLOAD(mslot) do{ const unsigned long long mw_=*(const __attribute__((address_space(3))) unsigned long long*)(shm3+LDS_MK+(mslot)+wid*256+r32*8); \
      mpk=(int)((((unsigned)mw_>>(4*hi))&0x0f0f0f0fu)|((((unsigned)(mw_>>32)>>(4*hi))&0x0f0f0f0fu)<<4)); }while(0)
  #define MBIT(W,P) __builtin_amdgcn_sbfe((W),(P),1)
  #define MAND(x,W,P) fand_bits((x),MBIT(W,P))
  int mpk;
  const int vb0=(int)(lds0+LDS_V)+((lane>>4)&1)*32+(lane&3)*8+(4*hi+((lane&15)>>2))*64;
  const char*Kbase=shm+LDS_K; bf16x8 kf[8];
  const lds_cptr shm3=(lds_cptr)shm; const lds_cptr kp0=shm3+LDS_K+hi*1024+r32*16; const lds_cptr vp0=shm3+LDS_V+((lane>>4)&1)*32+(lane&3)*8+(4*hi+((lane&15)>>2))*64;
  const int NT=(q0+QB)/KVBLK;
  DMA_M(0,0);DMA_M(1,MSLOTB);DMA_K(0,0);DMA_V(0,0);DMA_K(1,SLOTB);
  bf16x8 qr[4];
  #pragma unroll
  for(int d0=0;d0<4;++d0)qr[d0]=*reinterpret_cast<const bf16x8*>(&Qw[(long)r32*DM+d0*16+hi*8]);
  float mhat=0.f,l_reg=0.f;f32x16 o[2];o[0]=f32x16{};o[1]=f32x16{};const f32x16 negm=f32x16{};
  const int qrel=wid*QBLK+r32;
  #define CMASK(P0,P1,t) do{int jb_=(t)-(NT-4); if(jb_>=0)cmask(P0,P1,jb_,qrel,hi);}while(0)
  bool resc=false;
  #define START(P0,P1) do{ const float rm=rowmax(P0,P1); resc=false; \
    { const float dl=rm; mhat=fadd_s(mhat,dl); \
      _Pragma("unroll") for(int r=0;r<16;++r){P0[r]=fsub_s(P0[r],dl);P1[r]=fsub_s(P1[r],dl);} \
      } \
    _Pragma("unroll") for(int r=0;r<16;++r)P0[r]=__builtin_amdgcn_exp2f(P0[r]); }while(0)
  #define RESC() do{ if(resc){ asm volatile("s_waitcnt lgkmcnt(0)":::"memory"); \
      _Pragma("unroll") for(int d_=0;d_<2;++d_) _Pragma("unroll") for(int r=0;r<16;++r)o[d_][r]*=wsf[crow(r,hi)]; } }while(0)
  f32x16 pA0,pA1,pB0,pB1;
  int sl_prev=0,sl_cur=0,sl_next=SLOTB;
  #define ROT() do{sl_prev=sl_cur;sl_cur=sl_next;sl_next=(sl_next==(NSLOT-1)*SLOTB)?0:sl_next+SLOTB;}while(0)
  DMA_K(2,2*SLOTB);
  WAIT_BAR(3);
  qkt(pA0,pA1,Kbase,qr,negm,r32,hi);asm volatile("s_nop 15\n\ts_nop 7":"+v"(pA0),"+v"(pA1));CMASK(pA0,pA1,0);
  START(pA0,pA1);
  _Pragma("unroll") for(int r=0;r<16;++r)pA1[r]=__builtin_amdgcn_exp2f(pA1[r]);
  MLOAD(0); _Pragma("unroll") for(int r=0;r<16;++r){ pA0[r]=MAND(pA0[r],mpk,(r&3)+8*(r>>2)); pA1[r]=MAND(pA1[r],mpk,(r&3)+8*(r>>2)+4); }
  WAIT_BAR(0);
  DMA_K(3,0);DMA_V(1,SLOTB);DMA_M(2,2*MSLOTB);
  ROT();
  kload8(kf,kp0+sl_cur);
  WAIT_BAR(3);
  s16x4 vlo[8],vhi[8]; u32x4 pw0,pw1,pw2,pw3;
  #define PKW(P,B) cvtpk_s(P[B],P[B+1])
  #define PAF(k) __builtin_bit_cast(bf16x8,pw##k)
  #define VFR(i) (bf16x8){vlo[i][0],vlo[i][1],vlo[i][2],vlo[i][3],vhi[i][0],vhi[i][1],vhi[i][2],vhi[i][3]}
  #define PIN(x) asm volatile("":"+v"(x))
  #define MX3(a,b,c) __builtin_fmaxf(__builtin_fmaxf((a),(b)),(c))
  #define GAPA(MF,A0,A1,A2,A3,W0,W1,PW) do{ MF; sacc+=A0; sacc+=A1; sacc+=A2; sacc+=A3; PIN(sacc); W0; W1; PIN(PW); SBAR(); }while(0)
  #define EX(v) __builtin_amdgcn_exp2f(v)
  #define GAPB(MF,X,B,W) do{ MF; X[B]=MAND(EX(X[B]),mpk,2*(B)+(W)); X[B+1]=MAND(EX(X[B+1]),mpk,2*(B)+(W)+1); X[B+2]=MAND(EX(X[B+2]),mpk,2*(B)+(W)+2); X[B+3]=MAND(EX(X[B+3]),mpk,2*(B)+(W)+3); PIN(X); SBAR(); }while(0)
  #define VRD(i) do{ vlo[i]=vtr(vp_+(((i)>>2)*4096+((i)&3)*1024)); vhi[i]=vtr(vp_+(((i)>>2)*4096+((i)&3)*1024+512)); }while(0)
  #define KRD(G,j) do{ if(G){ kload2(kf,kp0+sl_next,j); SBAR(); } }while(0)
  #define STEP(C0,C1,P0,P1,t,GK,GV,GL,GM) do{ SBAR(); \
    const lds_cptr vp_=vp0+sl_prev; \
    VRD(0); SBAR(); float sacc=(P0[0]+P0[1]); \
    GAPA(C0=__builtin_amdgcn_mfma_f32_32x32x16_bf16(kf[0],qr[0],negm,0,0,0), P0[2],P0[3],P0[4],P0[5],     pw0[0]=PKW(P0,0), pw0[1]=PKW(P0,2), pw0); \
    VRD(4); SBAR(); GAPA(C1=__builtin_amdgcn_mfma_f32_32x32x16_bf16(kf[1],qr[0],negm,0,0,0), P0[6],P0[7],P0[8],P0[9],     pw0[2]=PKW(P0,4), pw0[3]=PKW(P0,6), pw0); \
    VRD(1); SBAR(); GAPA(C0=__builtin_amdgcn_mfma_f32_32x32x16_bf16(kf[2],qr[1],C0,0,0,0),   P0[10],P0[11],P0[12],P0[13], pw1[0]=PKW(P0,8), pw1[1]=PKW(P0,10), pw1); \
    VRD(5); SBAR(); GAPA(C1=__builtin_amdgcn_mfma_f32_32x32x16_bf16(kf[3],qr[1],C1,0,0,0),   P0[14],P0[15],P1[0],P1[1],   pw1[2]=PKW(P0,12),pw1[3]=PKW(P0,14), pw1); \
    VRD(2); SBAR(); GAPA(C0=__builtin_amdgcn_mfma_f32_32x32x16_bf16(kf[4],qr[2],C0,0,0,0),   P1[2],P1[3],P1[4],P1[5],     pw2[0]=PKW(P1,0), pw2[1]=PKW(P1,2), pw2); \
    VRD(6); SBAR(); GAPA(C1=__builtin_amdgcn_mfma_f32_32x32x16_bf16(kf[5],qr[2],C1,0,0,0),   P1[6],P1[7],P1[8],P1[9],     pw2[2]=PKW(P1,4), pw2[3]=PKW(P1,6), pw2); \
    VRD(3); SBAR(); GAPA(C0=__builtin_amdgcn_mfma_f32_32x32x16_bf16(kf[6],qr[3],C0,0,0,0),   P1[10],P1[11],P1[12],P1[13], pw3[0]=PKW(P1,8), pw3[1]=PKW(P1,10), pw3); \
    VRD(7); SBAR(); GAPA(C1=__builtin_amdgcn_mfma_f32_32x32x16_bf16(kf[7],qr[3],C1,0,0,0),   P1[14],P1[15],0.f,0.f,       pw3[2]=PKW(P1,12),pw3[3]=PKW(P1,14), pw3); \
    l_reg+=sacc; \
    if(GK){DMA_K((t)+3,sl_cur);} if(GV){DMA_V((t)+1,sl_next);} if(GM){DMA_M((t)+2,sl_prev>>2);} MLOAD(sl_cur>>2); \
    _Pragma("unroll") for(int r_=0;r_<16;++r_){C0[r_]-=mhat;C1[r_]-=mhat;} \
    CMASK(C0,C1,t); \
    { float a=MX3(C0[0],C0[1],C1[0]),b=MX3(C0[2],C0[3],C1[1]); a=MX3(a,C1[2],C1[3]); \
      _Pragma("unroll") for(int r=4;r<16;r+=4){a=MX3(a,C0[r],C0[r+1]);b=MX3(b,C0[r+2],C0[r+3]);a=MX3(a,C1[r],C1[r+1]);b=MX3(b,C1[r+2],C1[r+3]);} \
      float rm=__builtin_fmaxf(a,b); { auto rr=__builtin_amdgcn_permlane32_swap(__float_as_uint(rm),__float_as_uint(rm),false,false); rm=__builtin_fmaxf(__uint_as_float(rr[0]),__uint_as_float(rr[1])); } \
      resc=false; \
      if(__builtin_expect(__any(rm>(float)THRL),0)){ const float dl=__builtin_fmaxf(rm,0.f); mhat+=dl; \
        _Pragma("unroll") for(int r=0;r<16;++r){C0[r]-=dl;C1[r]-=dl;} \
        \
        const float f=__builtin_amdgcn_exp2f(-dl); l_reg*=f; if(hi==0)wsf[r32]=f; resc=true; } } \
    SBAR(); \
    GAPB(o[0]=__builtin_amdgcn_mfma_f32_32x32x16_bf16(PAF(0),VFR(0),o[0],0,0,0), C0,0,0); \
    GAPB(o[1]=__builtin_amdgcn_mfma_f32_32x32x16_bf16(PAF(0),VFR(4),o[1],0,0,0), C0,4,0); \
    KRD(GL,0); GAPB(o[0]=__builtin_amdgcn_mfma_f32_32x32x16_bf16(PAF(1),VFR(1),o[0],0,0,0), C0,8,0); \
    KRD(GL,1); GAPB(o[1]=__builtin_amdgcn_mfma_f32_32x32x16_bf16(PAF(1),VFR(5),o[1],0,0,0), C0,12,0); \
    KRD(GL,2); GAPB(o[0]=__builtin_amdgcn_mfma_f32_32x32x16_bf16(PAF(2),VFR(2),o[0],0,0,0), C1,0,4); \
    KRD(GL,3); GAPB(o[1]=__builtin_amdgcn_mfma_f32_32x32x16_bf16(PAF(2),VFR(6),o[1],0,0,0), C1,4,4); \
    GAPB(o[0]=__builtin_amdgcn_mfma_f32_32x32x16_bf16(PAF(3),VFR(3),o[0],0,0,0), C1,8,4); \
    GAPB(o[1]=__builtin_amdgcn_mfma_f32_32x32x16_bf16(PAF(3),VFR(7),o[1],0,0,0), C1,12,4); \
    }while(0)
  int t=1;
  #undef CMASK
  #define CMASK(P0,P1,t) do{}while(0)
  for(;t+5<NT;t+=2){
    STEP(pB0,pB1,pA0,pA1,t,true,true,true,true);     WAIT_BAR(3); RESC(); ROT();
    STEP(pA0,pA1,pB0,pB1,t+1,true,true,true,true);   WAIT_BAR(3); RESC(); ROT();
  }
  #undef CMASK
  #define CMASK(P0,P1,t) do{int jb_=(t)-(NT-4); if(jb_>=0)cmask(P0,P1,jb_,qrel,hi);}while(0)
  #define ENDW(tt) do{ if((tt)+3<NT){WAIT_BAR(3);} else if((tt)+2<NT){WAIT_BAR(2);} else {WAIT_BAR(0);} }while(0)
  for(;t+1<NT;t+=2){
    STEP(pB0,pB1,pA0,pA1,t,(t+3<NT),(t+1<NT),(t+1<NT),(t+2<NT));       ENDW(t);   RESC(); ROT();
    STEP(pA0,pA1,pB0,pB1,t+1,(t+4<NT),(t+2<NT),(t+2<NT),(t+3<NT));     ENDW(t+1); RESC(); ROT();
  }
  STEP(pB0,pB1,pA0,pA1,NT-1,false,false,false,false); RESC();
  { float sacc=pB0[0]+pB0[1]; _Pragma("unroll") for(int r=2;r<16;++r)sacc+=pB0[r]; _Pragma("unroll") for(int r=0;r<16;++r)sacc+=pB1[r]; l_reg+=sacc;
    pw0=(u32x4){PKW(pB0,0),PKW(pB0,2),PKW(pB0,4),PKW(pB0,6)};pw1=(u32x4){PKW(pB0,8),PKW(pB0,10),PKW(pB0,12),PKW(pB0,14)};pw2=(u32x4){PKW(pB1,0),PKW(pB1,2),PKW(pB1,4),PKW(pB1,6)};pw3=(u32x4){PKW(pB1,8),PKW(pB1,10),PKW(pB1,12),PKW(pB1,14)};
    SBAR(); pv(o,vb0+sl_cur,PAF(0),PAF(1),PAF(2),PAF(3)); }
  #undef PKW
  #undef PAF
  #undef VFR
  #undef PIN
  #undef MX3
  #undef GAPA
  #undef GAPB
  #undef EX
  #undef VRD
  #undef KRD
  #undef STEP
  #undef ENDW
  {auto rr=__builtin_amdgcn_permlane32_swap(__float_as_uint(l_reg),__float_as_uint(l_reg),false,false);l_reg=__uint_as_float(rr[0])+__uint_as_float(rr[1]);}
  if(hi==0)wsf[32+r32]=l_reg;asm volatile("s_waitcnt lgkmcnt(0)":::"memory");
  float rli[16];
  #pragma unroll
  for(int r=0;r<16;++r)rli[r]=__builtin_amdgcn_rcpf(wsf[32+crow(r,hi)]);
  bf16*Ow=O+(rowbase+q0+wid*QBLK)*OPITCH+h*D;
  { bf16*stg=(bf16*)(shm+LDS_OST)+wid*2048;
    #pragma unroll
    for(int r=0;r<16;++r){const int orow=crow(r,hi);
      #pragma unroll
      for(int d0=0;d0<2;++d0)stg[orow*64+d0*32+r32]=__float2bfloat16(o[d0][r]*rli[r]);}
    asm volatile("s_waitcnt lgkmcnt(0)":::"memory");
    #pragma unroll
    for(int i=0;i<4;++i){const int row=i*8+(lane>>3),ch=lane&7; const u32x4 v=*(const u32x4*)(stg+row*64+ch*8); ATTN_STORE16(Ow+(long)row*OPITCH+ch*8,v);} }
  asm volatile("s_waitcnt lgkmcnt(0)\n\ts_barrier":::"memory");
  #undef DMA_K
  #undef DMA_V
  #undef DMA_M
  #undef MLOAD
  #undef MBIT
  #undef MAND
  #undef CMASK
  #undef START
  #undef RESC
  #undef ROT
}
constexpr int ATTN_LDS_BYTES=LDS_BYTES;
struct AttnTensors { const bf16* Q; const bf16* K; const bf16* V; bf16* O; const unsigned long long* MK; };
struct AttnUnit { int bh; int qb; };
struct StaticOrder {
  int vcu, G;
  __device__ __forceinline__ explicit StaticOrder(int grid,int block):vcu((grid%8==0)?(block%8)*(grid/8)+block/8:block),G(grid){}
  __device__ __forceinline__ bool next(int i,AttnUnit&u)const{ const int pu=vcu+(i>>1)*G; if(pu>=256)return false; const int s=pu&15; u.bh=pu>>4; u.qb=(i&1)?31-s:s; return true; }
  __device__ __forceinline__ void a_ready(const AttnUnit&)const{}
  __device__ __forceinline__ void done(const AttnUnit&)const{}
};
struct QueueOrder {
  unsigned* ctr; __attribute__((address_space(3))) int* slot;
  __device__ __forceinline__ bool next(int,AttnUnit&u)const{ if(threadIdx.x==0)*slot=(int)__hip_atomic_fetch_add(ctr,1u,__ATOMIC_RELAXED,__HIP_MEMORY_SCOPE_AGENT); __syncthreads(); const int v=__builtin_amdgcn_readfirstlane(*slot); __syncthreads(); if(v>=512)return false; u.bh=v&15; u.qb=31-(v>>4); return true; }
  __device__ __forceinline__ void a_ready(const AttnUnit&)const{}
  __device__ __forceinline__ void done(const AttnUnit&)const{}
};
template<class Sched,int THRL=8> __device__ __forceinline__ void attn_phase(char*lds,const AttnTensors&T,const Sched&S){
  AttnUnit u;
  for(int i=0;S.next(i,u);++i){ S.a_ready(u); attn_unit<THRL>(u.bh/NHEAD,u.bh%NHEAD,u.qb,T.Q,T.K,T.V,T.O,T.MK,lds); S.done(u); }
}
#undef SBAR
#undef WAIT_BAR
}
constexpr int NWAVES = 8, NTHR = 512;
constexpr int BATCH = 2, SEQ = 8192, TT = BATCH * SEQ, DM = 1024, DFF = 2816, DIN = 3404, DINP = 3584;
constexpr int TOPK = 256;
constexpr float NORM_EPS = 1e-6f;
constexpr float C2 = 0.125f * 1.4426950408889634f;
constexpr size_t MiB = 1u << 20;
constexpr size_t WS_CTL = 0, CTL_ZERO_BYTES = 1 * MiB;
constexpr size_t WS_WA = 1 * MiB, WS_WB = 12 * MiB, WS_WIN = 35 * MiB / 2, WS_WQ = 57 * MiB / 2  , WS_WOUT = 25 * MiB;
constexpr size_t WS_BETA = 27 * MiB, WS_GLOG = 27 * MiB + MiB / 4, WS_WIDX = 27 * MiB + MiB / 2, WS_GF = 27 * MiB + 3 * MiB / 4, WS_KIDX = 29 * MiB;
constexpr size_t WS_XN = 32 * MiB, WS_FB = 64 * MiB, WS_HID = 96 * MiB;
constexpr size_t WS_CQ = 64 * MiB, WS_KATT = 72 * MiB, WS_VATT = 88 * MiB, WS_GRAW = 104 * MiB, WS_GZ = 152 * MiB, WS_SPEC = 168 * MiB;
constexpr size_t WS_QF = 176 * MiB, WS_KF = 192 * MiB, WS_KTF = 208 * MiB, WS_VTF = 224 * MiB;
constexpr size_t WS_QRAWQ = 240 * MiB  , WS_QRAWI = 56 * MiB  , WS_Q = 32 * MiB, WS_QIDX = 48 * MiB;
constexpr size_t WS_MASK = 240 * MiB, WS_CAT = 104 * MiB;
constexpr size_t WS_WF = 136 * MiB, WS_UC = 1 * MiB, WS_QKF = 17 * MiB;
constexpr size_t WS_END = 256 * MiB;
constexpr int RING_BYTES = 131072, LDS_BYTES = 151552, LDS_MISC_OFF = LDS_BYTES - 64;
constexpr int CW_BAR = 4096, CW_BAR2 = 8192, CW_QUEUE = 16384;

#define GAS __attribute__((address_space(1)))
#define LAS __attribute__((address_space(3)))
typedef unsigned short bf16;
typedef unsigned v4u __attribute__((ext_vector_type(4)));
typedef unsigned v2u __attribute__((ext_vector_type(2)));
typedef float f32x4 __attribute__((ext_vector_type(4)));
#define LDS_WAIT() asm volatile("s_waitcnt lgkmcnt(0)" ::: "memory")

__device__ __forceinline__ unsigned f2bf(float f) { unsigned u = __builtin_bit_cast(unsigned, f); return (u + 0x7fffu + ((u >> 16) & 1u)) >> 16; }
__device__ __forceinline__ unsigned pk2(float lo, float hi) { return f2bf(lo) | (f2bf(hi) << 16); }
__device__ __forceinline__ float bf2f(unsigned short h) { return __builtin_bit_cast(float, (unsigned)h << 16); }
__device__ __forceinline__ float bflo(unsigned w) { return __builtin_bit_cast(float, w << 16); }
__device__ __forceinline__ float bfhi(unsigned w) { return __builtin_bit_cast(float, w & 0xffff0000u); }
#define SWZ_XOR(x_, m_) __builtin_bit_cast(float, __builtin_amdgcn_ds_swizzle(__builtin_bit_cast(int, (x_)), (((m_) << 10) | 0x1f)))
__device__ __forceinline__ float xor32f(float v) { auto rr = __builtin_amdgcn_permlane32_swap(__builtin_bit_cast(unsigned, v), __builtin_bit_cast(unsigned, v), false, false); return __builtin_bit_cast(float, (unsigned)(rr[0] ^ rr[1] ^ __builtin_bit_cast(unsigned, v))); }
__device__ __forceinline__ float wave_sum(float v) {
    v += SWZ_XOR(v, 1); v += SWZ_XOR(v, 2); v += SWZ_XOR(v, 4); v += SWZ_XOR(v, 8); v += SWZ_XOR(v, 16);
    auto rr = __builtin_amdgcn_permlane32_swap(__builtin_bit_cast(unsigned, v), __builtin_bit_cast(unsigned, v), false, false);
    return __builtin_bit_cast(float, (unsigned)rr[0]) + __builtin_bit_cast(float, (unsigned)rr[1]);
}
__device__ __forceinline__ float wave_max(float v) {
    v = fmaxf(v, SWZ_XOR(v, 1)); v = fmaxf(v, SWZ_XOR(v, 2)); v = fmaxf(v, SWZ_XOR(v, 4)); v = fmaxf(v, SWZ_XOR(v, 8)); v = fmaxf(v, SWZ_XOR(v, 16));
    auto rr = __builtin_amdgcn_permlane32_swap(__builtin_bit_cast(unsigned, v), __builtin_bit_cast(unsigned, v), false, false);
    return fmaxf(__builtin_bit_cast(float, (unsigned)rr[0]), __builtin_bit_cast(float, (unsigned)rr[1]));
}
__device__ __forceinline__ float sigmoid_f(float x) { return __builtin_amdgcn_rcpf(1.0f + __builtin_amdgcn_exp2f(-1.4426950408889634f * x)); }
__device__ __forceinline__ float silu2(float x) { return x * sigmoid_f(x); }
__device__ __forceinline__ void rope_cs(float pos, float invf, float& c, float& s) {
    const float ang = pos * invf; double rev = (double)ang * 0.15915494309189535; rev -= __builtin_floor(rev); const float r = (float)rev;
    s = __builtin_amdgcn_sinf(r); c = __builtin_amdgcn_cosf(r);
}

struct Args { const float* in[24]; float* out; unsigned char* ws; float invf_att[32]; float invf_idx[16]; int ph_lo, ph_hi; };
enum { I_X = 0, I_F1PRE, I_F1POST, I_F1G, I_F1U, I_F1D, I_MPRE, I_MPOST, I_WIN, I_QAG, I_WQB, I_WQIB, I_KLG, I_KLB, I_CONV, I_ALOG, I_DTB, I_GOUTG, I_WOUT, I_F2PRE, I_F2POST, I_F2G, I_F2U, I_F2D };

struct Frame {
    LAS unsigned char* lds;
    int tid, lane, wave, G, bid;
    unsigned char* ws;
};

__device__ __forceinline__ void transpose_item(const float* W, int Nsrc, int K, bf16* WT, int n0, int sc, int k0, LAS float* scr, int lane) {
#pragma unroll 8
    for (int i = 0; i < 32; ++i) { const int kk = 2 * i + (lane >> 5); scr[kk * 33 + (lane & 31)] = sc >= 0 ? W[(size_t)(k0 + kk) * Nsrc + sc] : 0.f; }
    LDS_WAIT(); asm volatile("" ::: "memory");
    const int c = lane & 7;
#pragma unroll
    for (int j = 0; j < 4; ++j) { const int n = (lane >> 3) + 8 * j; const LAS float* s = scr + (8 * c) * 33 + n;
        v4u o; o.x = pk2(s[0 * 33], s[1 * 33]); o.y = pk2(s[2 * 33], s[3 * 33]); o.z = pk2(s[4 * 33], s[5 * 33]); o.w = pk2(s[6 * 33], s[7 * 33]);
        *(GAS v4u*)(WT + (size_t)(n0 + n) * K + k0 + 8 * c) = o; }
    LDS_WAIT(); asm volatile("" ::: "memory");
}
__device__ __forceinline__ int inproj_src(int r) {
    if (r < 1280) return r;
    if (r < 3328) return r + 68;
    if (r < 3392) return 1280 + (r - 3328);
    if (r < 3396) return 1344 + (r - 3392);
    if (r < 3404) return r;
    return -1;
}
__device__ __forceinline__ void rms_row_to_bf16(const float* xrow, const float* g, bf16* orow, int lane) {
    const GAS f32x4* xr = (const GAS f32x4*)xrow + lane; const GAS f32x4* gr = (const GAS f32x4*)g + lane;
    f32x4 v[4]; float s = 0.f;
#pragma unroll
    for (int j = 0; j < 4; ++j) { v[j] = xr[64 * j]; s += (v[j].x * v[j].x + v[j].y * v[j].y) + (v[j].z * v[j].z + v[j].w * v[j].w); }
    const float rstd = 1.0f / sqrtf(wave_sum(s) * (1.f / DM) + NORM_EPS);
    GAS v2u* o8 = (GAS v2u*)orow + lane;
#pragma unroll
    for (int j = 0; j < 4; ++j) { const f32x4 gg = gr[64 * j]; v2u o; o.x = pk2(v[j].x * rstd * gg.x, v[j].y * rstd * gg.y); o.y = pk2(v[j].z * rstd * gg.z, v[j].w * rstd * gg.w); o8[64 * j] = o; }
}
__device__ __forceinline__ void conv_ffn_weights(Frame& F, const Args& A, int f) {
    LAS float* scr = (LAS float*)(F.lds + F.wave * 16384);
    const int gw = F.bid * NWAVES + F.wave, NGW = F.G * NWAVES, lane = F.lane;
    bf16* WA = (bf16*)(F.ws + WS_WA); bf16* WB = (bf16*)(F.ws + WS_WB);
    constexpr int I_A = (DM / 64) * (2 * DFF / 32), I_B = (DFF / 64) * (DM / 32);
    for (int it = gw; it < I_A + I_B; it += NGW) {
        int r = it;
        if (r < I_A) { const int nblk = 2 * DFF / 32, kb = r / nblk, nb = r % nblk, n0 = nb * 32;
            const int tile = n0 >> 8, within = n0 & 255; const bool up = within >= 128; const int sc = tile * 128 + (within & 127) + (lane & 31);
            const float* W = A.in[f ? (up ? I_F2U : I_F2G) : (up ? I_F1U : I_F1G)];
            transpose_item(W, DFF, DM, WA, n0, sc, kb * 64, scr, lane); continue; }
        r -= I_A;
        { const int nblk = DM / 32, kb = r / nblk, nb = r % nblk, n0 = nb * 32;
            transpose_item(A.in[f ? I_F2D : I_F1D], DM, DFF, WB, n0, n0 + (lane & 31), kb * 64, scr, lane); }
    }
}
__device__ __forceinline__ void p_prologue(Frame& F, const Args& A) {
    LAS float* scr = (LAS float*)(F.lds + F.wave * 16384);
    const int gw = F.bid * NWAVES + F.wave, NGW = F.G * NWAVES, lane = F.lane;
    bf16* WIN = (bf16*)(F.ws + WS_WIN); bf16* WQ = (bf16*)(F.ws + WS_WQ); bf16* WOUT = (bf16*)(F.ws + WS_WOUT);
    conv_ffn_weights(F, A, 0);
    constexpr int I_IN = (DM / 64) * (DINP / 32), I_Q = (256 / 64) * (768 / 32), I_O = (DM / 64) * (DM / 32);
    constexpr int NITEMS = I_IN + I_Q + I_O;
    for (int it = gw; it < NITEMS; it += NGW) {
        int r = it;
        if (r < I_IN) { const int nblk = DINP / 32, kb = r / nblk, nb = r % nblk, n0 = nb * 32;
            transpose_item(A.in[I_WIN], DIN, DM, WIN, n0, inproj_src(n0 + (lane & 31)), kb * 64, scr, lane); continue; }
        r -= I_IN;
        if (r < I_Q) { const int nblk = 768 / 32, kb = r / nblk, nb = r % nblk, n0 = nb * 32;
            if (n0 < 512) transpose_item(A.in[I_WQB], 512, 256, WQ, n0, n0 + (lane & 31), kb * 64, scr, lane);
            else transpose_item(A.in[I_WQIB], 256, 256, WQ, n0, n0 - 512 + (lane & 31), kb * 64, scr, lane);
            continue; }
        r -= I_Q;
        { const int nblk = DM / 32, kb = r / nblk, nb = r % nblk, n0 = nb * 32;
            transpose_item(A.in[I_WOUT], DM, DM, WOUT, n0, n0 + (lane & 31), kb * 64, scr, lane); }
    }
    bf16* XN = (bf16*)(F.ws + WS_XN);
    for (int m = gw; m < TT; m += NGW) rms_row_to_bf16(A.in[I_X] + (size_t)m * DM, A.in[I_F1PRE], XN + (size_t)m * DM, lane);
}

__device__ __forceinline__ void p_rowpass(Frame& F, const bf16* FB, const float* xin, const float* gpost, float scale, float* xout, const float* gnext, bf16* XN) {
    const int gw = F.bid * NWAVES + F.wave, NGW = F.G * NWAVES, lane = F.lane;
    for (int m = gw; m < TT; m += NGW) {
        const GAS v4u* fr = (const GAS v4u*)(FB + (size_t)m * DM) + lane;
        float f[16]; float s = 0.f;
#pragma unroll
        for (int j = 0; j < 2; ++j) { const v4u w = fr[64 * j];
            f[8 * j + 0] = bflo(w.x); f[8 * j + 1] = bfhi(w.x); f[8 * j + 2] = bflo(w.y); f[8 * j + 3] = bfhi(w.y); f[8 * j + 4] = bflo(w.z); f[8 * j + 5] = bfhi(w.z); f[8 * j + 6] = bflo(w.w); f[8 * j + 7] = bfhi(w.w); }
#pragma unroll
        for (int i = 0; i < 16; ++i) s += f[i] * f[i];
        const float rstd = 1.0f / sqrtf(wave_sum(s) * (1.f / DM) + NORM_EPS) * scale;
        float xn[16]; float s2 = 0.f;
#pragma unroll
        for (int j = 0; j < 2; ++j)
#pragma unroll
            for (int q = 0; q < 2; ++q) { const int c = 512 * j + 8 * lane + 4 * q; const f32x4 xi = *(const GAS f32x4*)(xin + (size_t)m * DM + c); const f32x4 gp = *(const GAS f32x4*)(gpost + c);
                f32x4 o;
#pragma unroll
                for (int i = 0; i < 4; ++i) { o[i] = xi[i] + f[8 * j + 4 * q + i] * rstd * gp[i]; xn[8 * j + 4 * q + i] = o[i]; s2 += o[i] * o[i]; }
                *(GAS f32x4*)(xout + (size_t)m * DM + c) = o; }
        if (gnext) {
            const float r2 = 1.0f / sqrtf(wave_sum(s2) * (1.f / DM) + NORM_EPS);
#pragma unroll
            for (int j = 0; j < 2; ++j) { const int c = 512 * j + 8 * lane; const f32x4 g0 = *(const GAS f32x4*)(gnext + c), g1 = *(const GAS f32x4*)(gnext + c + 4);
                v4u o; o.x = pk2(xn[8 * j + 0] * r2 * g0[0], xn[8 * j + 1] * r2 * g0[1]); o.y = pk2(xn[8 * j + 2] * r2 * g0[2], xn[8 * j + 3] * r2 * g0[3]);
                o.z = pk2(xn[8 * j + 4] * r2 * g1[0], xn[8 * j + 5] * r2 * g1[1]); o.w = pk2(xn[8 * j + 6] * r2 * g1[2], xn[8 * j + 7] * r2 * g1[3]);
                *(GAS v4u*)(XN + (size_t)m * DM + c) = o; }
        }
    }
}

__device__ __forceinline__ size_t fragA_idx(int unit, int i, int d) { const int rb = i >> 5, r = i & 31, ks = d >> 4, x = d & 15, c = x >> 3, h = (x >> 2) & 1, b = x & 3; return ((size_t)(unit * 2 + rb) * 8 + ks) * 512 + (h * 32 + r) * 8 + 4 * c + b; }
__device__ __forceinline__ size_t fragT_idx(int unit, int d, int j) { const int tc = d >> 5, r = d & 31, ks = j >> 4, y = j & 15, c = y >> 3, h = (y >> 2) & 1, b = y & 3; return ((size_t)(unit * 4 + tc) * 4 + ks) * 512 + (h * 32 + r) * 8 + 4 * c + b; }

__device__ __forceinline__ void p_prep1(Frame& F, const Args& A) {
    const int gw = F.bid * NWAVES + F.wave, NGW = F.G * NWAVES, lane = F.lane;
    bf16* CQ = (bf16*)(F.ws + WS_CQ); bf16* KATT = (bf16*)(F.ws + WS_KATT); const bf16* GRAW = (const bf16*)(F.ws + WS_GRAW); const float* SPEC = (const float*)(F.ws + WS_SPEC);
    __half* KIDX = (__half*)(F.ws + WS_KIDX); float* BETA = (float*)(F.ws + WS_BETA); float* GLOG = (float*)(F.ws + WS_GLOG); float* WIDX = (float*)(F.ws + WS_WIDX);
    bf16* QF = (bf16*)(F.ws + WS_QF); bf16* KF = (bf16*)(F.ws + WS_KF); bf16* KTF = (bf16*)(F.ws + WS_KTF); bf16* VTF = (bf16*)(F.ws + WS_VTF);
    const float* convw = A.in[I_CONV];
    for (int m = gw; m < TT; m += NGW) {
        const int t = m & (SEQ - 1); const float pos = (float)t;
        { GAS v2u* p = (GAS v2u*)(CQ + (size_t)m * 256) + lane; const v2u w = *p; const float a0 = bflo(w.x), a1 = bfhi(w.x), a2 = bflo(w.y), a3 = bfhi(w.y);
          const float rstd = 1.0f / sqrtf(wave_sum(a0 * a0 + a1 * a1 + a2 * a2 + a3 * a3) * (1.f / 256) + NORM_EPS); const f32x4 g = *(const GAS f32x4*)(A.in[I_QAG] + 4 * lane);
          v2u o; o.x = pk2(a0 * rstd * g[0], a1 * rstd * g[1]); o.y = pk2(a2 * rstd * g[2], a3 * rstd * g[3]); *p = o; }
        { const int hd = lane >> 3, d0 = (lane & 7) * 4; GAS v2u* p1 = (GAS v2u*)(KATT + (size_t)m * 512 + hd * 64 + d0); GAS v2u* p2 = (GAS v2u*)(KATT + (size_t)m * 512 + hd * 64 + d0 + 32);
          const v2u w1 = *p1, w2 = *p2; float x1[4] = {bflo(w1.x), bfhi(w1.x), bflo(w1.y), bfhi(w1.y)}, x2[4] = {bflo(w2.x), bfhi(w2.x), bflo(w2.y), bfhi(w2.y)}; float o1[4], o2[4];
#pragma unroll
          for (int i = 0; i < 4; ++i) { float c, s; rope_cs(pos, A.invf_att[d0 + i], c, s); o1[i] = x1[i] * c - x2[i] * s; o2[i] = x2[i] * c + x1[i] * s; }
          v2u a, b; a.x = pk2(o1[0], o1[1]); a.y = pk2(o1[2], o1[3]); b.x = pk2(o2[0], o2[1]); b.y = pk2(o2[2], o2[3]); *p1 = a; *p2 = b; }
        { const float v = SPEC[(size_t)m * 128 + lane]; const float mu = wave_sum(v) * (1.f / 64); const float xc = v - mu; const float var = wave_sum(xc * xc) * (1.f / 64);
          const float y = xc * (1.0f / sqrtf(var + NORM_EPS)) * A.in[I_KLG][lane] + A.in[I_KLB][lane];
          const float part = SWZ_XOR(y, 16); float c, s; rope_cs(pos, A.invf_idx[lane & 15], c, s);
          float o = y; if (lane < 16) o = y * c - part * s; else if (lane < 32) o = y * c + part * s;
          KIDX[(size_t)m * 64 + lane] = __float2half(o); }
        if (lane < 4) WIDX[(size_t)m * 4 + lane] = SPEC[(size_t)m * 128 + 64 + lane];
    }
    for (int blk = gw; blk < TT / 8; blk += NGW) {
        const int b = blk >> 10, n = (blk & 1023) >> 3, a = blk & 7; const int t0 = 64 * n + 8 * a; const size_t m0 = (size_t)b * SEQ + t0;
        const int gsub = lane >> 4, ks = (lane & 15) >> 1, hh = lane & 1; const int ch0 = 16 * ks + 4 * hh;
        if (lane < 32) { const size_t mm = m0 + (lane >> 2); const int hd = lane & 3; const float gb = SPEC[mm * 128 + 68 + hd], ga = SPEC[mm * 128 + 72 + hd];
          BETA[mm * 4 + hd] = sigmoid_f(gb);
          const float xx = ga + A.in[I_DTB][hd]; const float sp = fmaxf(xx, 0.f) + log1pf(__expf(-fabsf(xx)));
          GLOG[mm * 4 + hd] = -__expf(A.in[I_ALOG][hd]) * sp; }
#pragma unroll 1
        for (int pass = 0; pass < 3; ++pass) {
            const int cbase = pass * 512 + gsub * 128 + ch0; const int unit = (b * 4 + gsub) * 128 + n;
            float wc[4][8];
#pragma unroll
            for (int jj = 0; jj < 4; ++jj) { const f32x4 w0 = *(const GAS f32x4*)(convw + jj * 1536 + cbase), w1 = *(const GAS f32x4*)(convw + jj * 1536 + cbase + 8);
#pragma unroll
                for (int e = 0; e < 4; ++e) { wc[jj][e] = w0[e]; wc[jj][4 + e] = w1[e]; } }
            float y[8][8];
#pragma unroll
            for (int tk = 0; tk < 8; ++tk)
#pragma unroll
                for (int e = 0; e < 8; ++e) y[tk][e] = 0.f;
#pragma unroll
            for (int rr = 0; rr < 11; ++rr) { float x[8];
                if (t0 - 3 + rr >= 0) { const v2u w0 = *(const GAS v2u*)(GRAW + (m0 - 3 + rr) * 1536 + cbase), w1 = *(const GAS v2u*)(GRAW + (m0 - 3 + rr) * 1536 + cbase + 8);
                    x[0] = bflo(w0.x); x[1] = bfhi(w0.x); x[2] = bflo(w0.y); x[3] = bfhi(w0.y); x[4] = bflo(w1.x); x[5] = bfhi(w1.x); x[6] = bflo(w1.y); x[7] = bfhi(w1.y); }
                else {
#pragma unroll
                    for (int e = 0; e < 8; ++e) x[e] = 0.f; }
#pragma unroll
                for (int jj = 0; jj < 4; ++jj) { const int tk = rr - jj; if (tk >= 0 && tk < 8) {
#pragma unroll
                    for (int e = 0; e < 8; ++e) y[tk][e] += wc[jj][e] * x[e]; } } }
#pragma unroll
            for (int tk = 0; tk < 8; ++tk) { float ss = 0.f;
#pragma unroll
                for (int e = 0; e < 8; ++e) { y[tk][e] = silu2(y[tk][e]); ss += y[tk][e] * y[tk][e]; }
                if (pass < 2) { ss += SWZ_XOR(ss, 1); ss += SWZ_XOR(ss, 2); ss += SWZ_XOR(ss, 4); ss += SWZ_XOR(ss, 8); const float r = 1.0f / sqrtf(ss + NORM_EPS);
#pragma unroll
                    for (int e = 0; e < 8; ++e) y[tk][e] *= r; } }
            if (pass < 2) { bf16* dst = pass == 0 ? QF : KF;
#pragma unroll
                for (int tk = 0; tk < 8; ++tk) { const int i = 8 * a + tk; v4u o; o.x = pk2(y[tk][0], y[tk][1]); o.y = pk2(y[tk][2], y[tk][3]); o.z = pk2(y[tk][4], y[tk][5]); o.w = pk2(y[tk][6], y[tk][7]);
                    *(GAS v4u*)(dst + ((size_t)(unit * 2 + (i >> 5)) * 8 + ks) * 512 + (hh * 32 + (i & 31)) * 8) = o; } }
            if (pass >= 1) { bf16* dst = pass == 1 ? KTF : VTF;
#pragma unroll
                for (int e = 0; e < 8; ++e) { const int d = ch0 + (e & 3) + 8 * (e >> 2); const size_t base = ((size_t)(unit * 4 + (d >> 5)) * 4 + (a >> 1)) * 512 + (d & 31) * 8 + 4 * (a & 1);
                    v2u o0, o1; o0.x = pk2(y[0][e], y[1][e]); o0.y = pk2(y[2][e], y[3][e]); o1.x = pk2(y[4][e], y[5][e]); o1.y = pk2(y[6][e], y[7][e]);
                    *(GAS v2u*)(dst + base) = o0; *(GAS v2u*)(dst + base + 32 * 8) = o1; } }
        }
    }
}
__device__ __forceinline__ void gdn_pre_unit(Frame& F, int unit, LAS unsigned char* wl);
__device__ __forceinline__ void p_prep2(Frame& F, const Args& A, int gw, int NGW) {
    const int lane = F.lane;
    const bf16* QRAWQ = (const bf16*)(F.ws + WS_QRAWQ); const bf16* QRAWI = (const bf16*)(F.ws + WS_QRAWI); bf16* Q = (bf16*)(F.ws + WS_Q); __half* QIDX = (__half*)(F.ws + WS_QIDX);
    for (int m = gw; m < TT; m += NGW) {
        const int t = m & (SEQ - 1); const float pos = (float)t;
        { const int hd = lane >> 3, d0 = (lane & 7) * 4; const v2u w1 = *(const GAS v2u*)(QRAWQ + (size_t)m * 512 + hd * 64 + d0), w2 = *(const GAS v2u*)(QRAWQ + (size_t)m * 512 + hd * 64 + d0 + 32);
          float x1[4] = {bflo(w1.x), bfhi(w1.x), bflo(w1.y), bfhi(w1.y)}, x2[4] = {bflo(w2.x), bfhi(w2.x), bflo(w2.y), bfhi(w2.y)}; float o1[4], o2[4];
#pragma unroll
          for (int i = 0; i < 4; ++i) { float c, s; rope_cs(pos, A.invf_att[d0 + i], c, s); o1[i] = (x1[i] * c - x2[i] * s) * C2; o2[i] = (x2[i] * c + x1[i] * s) * C2; }
          v2u a, b; a.x = pk2(o1[0], o1[1]); a.y = pk2(o1[2], o1[3]); b.x = pk2(o2[0], o2[1]); b.y = pk2(o2[2], o2[3]);
          *(GAS v2u*)(Q + (size_t)m * 512 + hd * 64 + d0) = a; *(GAS v2u*)(Q + (size_t)m * 512 + hd * 64 + d0 + 32) = b; }
        { const int hd = lane >> 4, i = lane & 15; const bf16* src = QRAWI + (size_t)m * 256 + hd * 64; __half* dst = QIDX + (size_t)m * 256 + hd * 64;
          const float x1 = bf2f(src[i]), x2 = bf2f(src[i + 16]); float c, s; rope_cs(pos, A.invf_idx[i], c, s);
          dst[i] = __float2half(x1 * c - x2 * s); dst[i + 16] = __float2half(x2 * c + x1 * s);
          dst[32 + 2 * i] = __float2half(bf2f(src[32 + 2 * i])); dst[33 + 2 * i] = __float2half(bf2f(src[33 + 2 * i])); }
    }
}

__device__ __forceinline__ unsigned sortable(float x) { const unsigned u = __builtin_bit_cast(unsigned, x); return (u & 0x80000000u) ? ~u : (u | 0x80000000u); }
__device__ __forceinline__ void p_dsa_naive(Frame& F, const Args& A, int first_blk, int nblk) {
    const int tid = F.tid, lane = F.lane, wave = F.wave;
    const bf16* Q = (const bf16*)(F.ws + WS_Q); const bf16* KATT = (const bf16*)(F.ws + WS_KATT); const bf16* VATT = (const bf16*)(F.ws + WS_VATT);
    const __half* QIDX = (const __half*)(F.ws + WS_QIDX); const __half* KIDX = (const __half*)(F.ws + WS_KIDX); const float* WIDX = (const float*)(F.ws + WS_WIDX);
    unsigned long long* MASK = (unsigned long long*)(F.ws + WS_MASK); bf16* CAT = (bf16*)(F.ws + WS_CAT);
    LAS float* qi = (LAS float*)(F.lds);
    LAS float* wv = (LAS float*)(F.lds + 1024);
    LAS int* cntb = (LAS int*)(F.lds + 1280);
    LAS unsigned long long* mw = (LAS unsigned long long*)(F.lds + 2048);
    LAS int* pref = (LAS int*)(F.lds + 4096);
    LAS int* sel = (LAS int*)(F.lds + 8192);
    LAS float* P = (LAS float*)(F.lds + 16384);
    int par = 0;
    for (int m = F.bid - first_blk; m < TT; m += nblk) {
        const int b = m >> 13, t = m & (SEQ - 1);
        __syncthreads();
        if (tid < 256) qi[tid] = __half2float(QIDX[(size_t)m * 256 + tid]);
        if (tid < 4) wv[tid] = WIDX[(size_t)m * 4 + tid];
        __syncthreads();
        unsigned key[16];
#pragma unroll
        for (int j = 0; j < 16; ++j) { const int s = tid + 512 * j; key[j] = 0u;
            if (s <= t) { const v4u* kp = (const v4u*)(KIDX + ((size_t)b * SEQ + s) * 64); float d0 = 0.f, d1 = 0.f, d2 = 0.f, d3 = 0.f;
#pragma unroll
                for (int c = 0; c < 8; ++c) { const v4u w = kp[c]; const unsigned ww[4] = {w.x, w.y, w.z, w.w};
#pragma unroll
                    for (int e = 0; e < 4; ++e) { const __half2 h2 = __builtin_bit_cast(__half2, ww[e]); const float k0 = __low2float(h2), k1 = __high2float(h2); const int d = c * 8 + e * 2;
                        d0 += qi[d] * k0 + qi[d + 1] * k1; d1 += qi[64 + d] * k0 + qi[64 + d + 1] * k1; d2 += qi[128 + d] * k0 + qi[128 + d + 1] * k1; d3 += qi[192 + d] * k0 + qi[192 + d + 1] * k1; } }
                const float sc = wv[0] * fmaxf(d0, 0.f) + wv[1] * fmaxf(d1, 0.f) + wv[2] * fmaxf(d2, 0.f) + wv[3] * fmaxf(d3, 0.f);
                key[j] = sortable(sc); } }
#define BCOUNT(PRED, OUT) do { int c_ = 0; _Pragma("unroll") for (int j = 0; j < 16; ++j) { const int s = tid + 512 * j; (void)s; c_ += (int)__popcll(__ballot(PRED)); } \
            if (lane == 0) cntb[par * 8 + wave] = c_; __syncthreads(); int t_ = 0; _Pragma("unroll") for (int w_ = 0; w_ < 8; ++w_) t_ += cntb[par * 8 + w_]; par ^= 1; OUT = t_; } while (0)
        unsigned vstar = 1u; int cutoff = SEQ;
        if (t + 1 > TOPK) {
            unsigned cur = 0u;
            for (int bit = 31; bit >= 0; --bit) { const unsigned v = cur | (1u << bit); int c; BCOUNT(key[j] >= v, c); if (c >= TOPK) cur = v; }
            vstar = cur; int cgt; BCOUNT(key[j] > vstar, cgt); const int need = TOPK - cgt;
            int lo = 0, hi = SEQ - 1;
            while (lo < hi) { const int mid = (lo + hi) >> 1; int c; BCOUNT(key[j] == vstar && s <= mid, c); if (c >= need) hi = mid; else lo = mid + 1; }
            cutoff = lo;
        }
        bool selj[16];
#pragma unroll
        for (int j = 0; j < 16; ++j) { const int s = tid + 512 * j; selj[j] = (t + 1 > TOPK) ? (key[j] > vstar || (key[j] == vstar && s <= cutoff)) : (s <= t);
            const unsigned long long bm = __ballot(selj[j]); if (lane == 0) { mw[8 * j + wave] = bm; MASK[((size_t)(b * 128 + 8 * j + wave)) * SEQ + t] = bm; } }
        __syncthreads();
        if (wave == 0) { int c0 = (int)__popcll(mw[2 * lane]), c1 = (int)__popcll(mw[2 * lane + 1]); int s = c0 + c1, inc = s;
#pragma unroll
            for (int o = 1; o < 64; o <<= 1) { const int u = __shfl_up(inc, o); if (lane >= o) inc += u; }
            const int ex = inc - s; pref[2 * lane] = ex; pref[2 * lane + 1] = ex + c0; }
        __syncthreads();
#pragma unroll
        for (int j = 0; j < 16; ++j) if (selj[j]) { const int wd = 8 * j + wave; const int pos = pref[wd] + (int)__popcll(mw[wd] & ((1ull << lane) - 1ull)); if (pos < TOPK) sel[pos] = tid + 512 * j; }
        __syncthreads();
        const int nsel = (t + 1 < TOPK) ? t + 1 : TOPK;
        { const int h = wave; float qv[64];
          { const v4u* qp = (const v4u*)(Q + (size_t)m * 512 + h * 64);
#pragma unroll
            for (int c = 0; c < 8; ++c) { const v4u w = qp[c]; qv[8 * c] = bflo(w.x); qv[8 * c + 1] = bfhi(w.x); qv[8 * c + 2] = bflo(w.y); qv[8 * c + 3] = bfhi(w.y); qv[8 * c + 4] = bflo(w.z); qv[8 * c + 5] = bfhi(w.z); qv[8 * c + 6] = bflo(w.w); qv[8 * c + 7] = bfhi(w.w); } }
          float lg[4];
#pragma unroll
          for (int kk = 0; kk < 4; ++kk) { const int idx = lane + 64 * kk; lg[kk] = -INFINITY;
            if (idx < nsel) { const int s = sel[idx]; const v4u* kp = (const v4u*)(KATT + ((size_t)b * SEQ + s) * 512 + h * 64); float d = 0.f;
#pragma unroll
                for (int c = 0; c < 8; ++c) { const v4u w = kp[c]; d += qv[8 * c] * bflo(w.x) + qv[8 * c + 1] * bfhi(w.x) + qv[8 * c + 2] * bflo(w.y) + qv[8 * c + 3] * bfhi(w.y) + qv[8 * c + 4] * bflo(w.z) + qv[8 * c + 5] * bfhi(w.z) + qv[8 * c + 6] * bflo(w.w) + qv[8 * c + 7] * bfhi(w.w); }
                lg[kk] = d; } }
          const float mx = wave_max(fmaxf(fmaxf(lg[0], lg[1]), fmaxf(lg[2], lg[3]))); float ps = 0.f;
#pragma unroll
          for (int kk = 0; kk < 4; ++kk) { const float p = __builtin_amdgcn_exp2f(lg[kk] - mx); ps += p; P[h * 256 + lane + 64 * kk] = p; }
          const float tot = wave_sum(ps);
          LDS_WAIT(); asm volatile("" ::: "memory");
          float acc = 0.f;
          for (int idx = 0; idx < nsel; ++idx) { const int s = sel[idx]; acc += P[h * 256 + idx] * bf2f(VATT[((size_t)b * SEQ + s) * 512 + h * 64 + lane]); }
          CAT[(size_t)m * 1024 + h * 64 + lane] = (bf16)f2bf(acc / tot); }
    }
#undef BCOUNT
}

__device__ __forceinline__ void p_gdn_naive(Frame& F, const Args& A, int bh) {
    const int tid = F.tid, lane = F.lane, wave = F.wave; const int b = bh >> 2, h = bh & 3; const int e = tid & 127, ds = tid >> 7;
    const bf16* QF = (const bf16*)(F.ws + WS_QF); const bf16* KF = (const bf16*)(F.ws + WS_KF); const bf16* VTF = (const bf16*)(F.ws + WS_VTF); const bf16* GZ = (const bf16*)(F.ws + WS_GZ);
    const float* BETA = (const float*)(F.ws + WS_BETA); const float* GLOG = (const float*)(F.ws + WS_GLOG); bf16* CAT = (bf16*)(F.ws + WS_CAT);
    LAS float* red1 = (LAS float*)(F.lds + 65536); LAS float* red2 = (LAS float*)(F.lds + 65536 + 2048); LAS float* small = (LAS float*)(F.lds + 65536 + 4096);
    float S[32];
#pragma unroll
    for (int i = 0; i < 32; ++i) S[i] = 0.f;
    const float gout = A.in[I_GOUTG][e];
    for (int t = 0; t < SEQ; ++t) {
        const size_t row = (size_t)b * SEQ + t; const int unit = bh * 128 + (t >> 6), i = t & 63;
        float kk[32], qq[32];
#pragma unroll
        for (int c = 0; c < 32; ++c) { kk[c] = bf2f(KF[fragA_idx(unit, i, ds * 32 + c)]); qq[c] = bf2f(QF[fragA_idx(unit, i, ds * 32 + c)]); }
        const float v = bf2f(VTF[fragT_idx(unit, e, i)]); const float beta = BETA[row * 4 + h]; const float a = __expf(GLOG[row * 4 + h]);
        float part = 0.f;
#pragma unroll
        for (int c = 0; c < 32; ++c) part += kk[c] * S[c];
        red1[ds * 128 + e] = part; __syncthreads();
        const float kS = (red1[e] + red1[128 + e]) + (red1[256 + e] + red1[384 + e]);
        const float vn = beta * (v - a * kS);
        float po = 0.f;
#pragma unroll
        for (int c = 0; c < 32; ++c) { S[c] = a * S[c] + kk[c] * vn; po += qq[c] * S[c]; }
        red2[ds * 128 + e] = po; __syncthreads();
        float o = 0.f;
        if (ds == 0) { o = ((red2[e] + red2[128 + e]) + (red2[256 + e] + red2[384 + e])) * 0.08838834764831845f; const float ss = wave_sum(o * o); if (lane == 0) small[wave] = ss; }
        __syncthreads();
        if (ds == 0) { const float rstd = 1.0f / sqrtf((small[0] + small[1]) * (1.f / 128) + NORM_EPS); const float z = bf2f(GZ[row * 512 + h * 128 + e]);
            CAT[row * 1024 + 512 + h * 128 + e] = (bf16)f2bf(o * rstd * gout * silu2(z)); }
    }
}

typedef short bf16x8 __attribute__((ext_vector_type(8)));
typedef float f32x16 __attribute__((ext_vector_type(16)));
typedef float f32x2_t __attribute__((ext_vector_type(2))); typedef __bf16 bf16x2_t __attribute__((ext_vector_type(2)));
__device__ __forceinline__ unsigned cvtpk(float lo, float hi) { f32x2_t v = {lo, hi}; bf16x2_t b = __builtin_convertvector(v, bf16x2_t); return __builtin_bit_cast(unsigned, b); }
#define PACK8(A_, B_) __builtin_bit_cast(bf16x8, (v4u){cvtpk((A_)[(B_)], (A_)[(B_) + 1]), cvtpk((A_)[(B_) + 2], (A_)[(B_) + 3]), cvtpk((A_)[(B_) + 4], (A_)[(B_) + 5]), cvtpk((A_)[(B_) + 6], (A_)[(B_) + 7])})
#define MFMA32(a_, b_, c_) __builtin_amdgcn_mfma_f32_32x32x16_bf16((a_), (b_), (c_), 0, 0, 0)
constexpr int GF_STRIDE = 192;
constexpr float GDN_SCALE = 0.08838834764831845f;
__device__ __forceinline__ void gdn_pre_unit(Frame& F, int unit, LAS unsigned char* wl) {
    int lane = F.lane; asm volatile("" : "+v"(lane));
    const int c = lane & 31, half = lane >> 5;
    const int bh = unit >> 7, n = unit & 127, b = bh >> 2, h = bh & 3; const size_t m0 = (size_t)b * SEQ + 64 * n;
    const bf16* QF = (const bf16*)(F.ws + WS_QF); const bf16* KF = (const bf16*)(F.ws + WS_KF); const bf16* KTF = (const bf16*)(F.ws + WS_KTF); const bf16* VTF = (const bf16*)(F.ws + WS_VTF);
    const float* BETA = (const float*)(F.ws + WS_BETA); const float* GLOG = (const float*)(F.ws + WS_GLOG);
    bf16* WF = (bf16*)(F.ws + WS_WF); bf16* UC = (bf16*)(F.ws + WS_UC); bf16* QKF = (bf16*)(F.ws + WS_QKF); float* GF = (float*)(F.ws + WS_GF);
    { unsigned wb_ = (unsigned)(uintptr_t)wl; asm volatile("" : "+v"(wb_)); wl = (LAS unsigned char*)(uintptr_t)wb_; }
    LAS float* AT = (LAS float*)wl; LAS float* Tl = (LAS float*)(wl + 16384); LAS float* gcl = (LAS float*)(wl + 32768); LAS float* btl = gcl + 64; LAS float* bgl = gcl + 128;
    const float gl = GLOG[(m0 + lane) * 4 + h], bt = BETA[(m0 + lane) * 4 + h];
    float gc = gl;
#pragma unroll
    for (int o = 1; o < 64; o <<= 1) { const float u = __builtin_bit_cast(float, __builtin_amdgcn_ds_bpermute((lane - o) << 2, __builtin_bit_cast(int, gc))); if (lane >= o) gc += u; }
    const float gc63 = __builtin_bit_cast(float, __builtin_amdgcn_readlane(__builtin_bit_cast(int, gc), 63));
    gcl[lane] = gc; btl[lane] = bt; bgl[lane] = bt * __expf(gc);
    GF[(size_t)unit * GF_STRIDE + lane] = __expf(gc) * GDN_SCALE; GF[(size_t)unit * GF_STRIDE + 64 + lane] = __expf(gc63 - gc); if (lane == 0) GF[(size_t)unit * GF_STRIDE + 128] = __expf(gc63);
    bf16x8 kf[2][8];
#pragma unroll
    for (int rb = 0; rb < 2; ++rb)
#pragma unroll
        for (int ks = 0; ks < 8; ++ks) kf[rb][ks] = *(const GAS bf16x8*)(KF + ((size_t)(unit * 2 + rb) * 8 + ks) * 512 + lane * 8);
    LDS_WAIT(); asm volatile("" ::: "memory");
#pragma unroll
    for (int tile = 0; tile < 3; ++tile) { const int tr = tile >= 1, tc = tile >= 2; f32x16 acc = {};
#pragma unroll
        for (int ks = 0; ks < 8; ++ks) acc = MFMA32(kf[tr][ks], kf[tc][ks], acc);
        const int C = 32 * tc + c; const float gcC = gcl[C];
#pragma unroll
        for (int reg = 0; reg < 16; ++reg) { const int R = 32 * tr + (reg & 3) + 8 * (reg >> 2) + 4 * half; AT[C * 64 + R] = btl[R] * acc[reg] * __expf(gcl[R] - gcC); } }
#pragma unroll
    for (int tile = 0; tile < 3; ++tile) { const int tj = tile >= 2, ti = tile >= 1; f32x16 acc = {};
#pragma unroll
        for (int ks = 0; ks < 8; ++ks) acc = MFMA32(kf[tj][ks], *(const GAS bf16x8*)(QF + ((size_t)(unit * 2 + ti) * 8 + ks) * 512 + lane * 8), acc);
        asm volatile("" ::: "memory");
        const int I = 32 * ti + c; const float gcI = gcl[I]; float v[16];
#pragma unroll
        for (int reg = 0; reg < 16; ++reg) { const int J = 32 * tj + (reg & 3) + 8 * (reg >> 2) + 4 * half; v[reg] = (J <= I) ? acc[reg] * __expf(gcI - gcl[J]) * GDN_SCALE : 0.f; }
        *(GAS bf16x8*)(QKF + ((size_t)(unit * 2 + ti) * 4 + 2 * tj) * 512 + lane * 8) = PACK8(v, 0);
        *(GAS bf16x8*)(QKF + ((size_t)(unit * 2 + ti) * 4 + 2 * tj + 1) * 512 + lane * 8) = PACK8(v, 8); }
    LDS_WAIT(); asm volatile("" ::: "memory");
    Tl[63 * 64 + lane] = (lane == 63) ? 1.f : 0.f;
#pragma unroll 1
    for (int j = 62; j >= 0; --j) { float acc = (lane == j) ? 1.f : 0.f;
#pragma unroll 4
        for (int k = j + 1; k < 64; ++k) acc -= Tl[k * 64 + lane] * AT[j * 64 + k];
        Tl[j * 64 + lane] = acc; }
    LDS_WAIT(); asm volatile("" ::: "memory");
    LAS unsigned char* TbF = wl; LAS unsigned char* TbgF = wl + 8192;
    { const int rb = lane >> 5, r = lane & 31;
#pragma unroll 1
      for (int ks = 0; ks < 4; ++ks)
#pragma unroll
        for (int hh = 0; hh < 2; ++hh) { float x[8], y[8];
#pragma unroll
            for (int jj = 0; jj < 8; ++jj) { const int jt = 16 * ks + 8 * (jj >> 2) + 4 * hh + (jj & 3); const float tv = Tl[jt * 64 + lane]; x[jj] = tv * btl[jt]; y[jj] = tv * bgl[jt]; }
            *(LAS bf16x8*)(TbF + ((rb * 4 + ks) * 64 + hh * 32 + r) * 16) = PACK8(x, 0); *(LAS bf16x8*)(TbgF + ((rb * 4 + ks) * 64 + hh * 32 + r) * 16) = PACK8(y, 0); } }
    LDS_WAIT(); asm volatile("" ::: "memory");
#pragma unroll 1
    for (int rb = 0; rb < 2; ++rb)
#pragma unroll 1
        for (int cb = 0; cb < 4; ++cb) { f32x16 acc = {};
#pragma unroll
            for (int ks = 0; ks < 4; ++ks) acc = MFMA32(*(const LAS bf16x8*)(TbF + ((rb * 4 + ks) * 64 + lane) * 16), *(const GAS bf16x8*)(VTF + ((size_t)(unit * 4 + cb) * 4 + ks) * 512 + lane * 8), acc);
            bf16* dst = UC + (((size_t)(unit * 2 + rb) * 128 + 32 * cb + c) * 2 + half) * 16;
            *(GAS bf16x8*)dst = PACK8(acc, 0); *(GAS bf16x8*)(dst + 8) = PACK8(acc, 8); }
#pragma unroll 1
    for (int tdk = 0; tdk < 4; ++tdk)
#pragma unroll 1
        for (int rb = 0; rb < 2; ++rb) { f32x16 acc = {};
#pragma unroll
            for (int ks = 0; ks < 4; ++ks) acc = MFMA32(*(const GAS bf16x8*)(KTF + ((size_t)(unit * 4 + tdk) * 4 + ks) * 512 + lane * 8), *(const LAS bf16x8*)(TbgF + ((rb * 4 + ks) * 64 + lane) * 16), acc);
            *(GAS bf16x8*)(WF + ((size_t)(unit * 2 + rb) * 8 + 2 * tdk) * 512 + lane * 8) = PACK8(acc, 0);
            *(GAS bf16x8*)(WF + ((size_t)(unit * 2 + rb) * 8 + 2 * tdk + 1) * 512 + lane * 8) = PACK8(acc, 8); }
    LDS_WAIT(); asm volatile("" ::: "memory");
}

constexpr int SC_BUF = 57344, SC_W = 0, SC_Q = 16384, SC_KT = 32768, SC_QK = 49152, SC_OST = 2 * SC_BUF, OST_LD = 132, SC_GF = SC_OST + 64 * OST_LD * 4, SC_END = SC_GF + 2 * GF_STRIDE * 4;
__device__ __forceinline__ void p_gdn_scan(Frame& F, const Args& A, int bh) {
    const int lane = F.lane, wave = F.wave, c = lane & 31, half = lane >> 5; const int b = bh >> 2, h = bh & 3;
    const bf16* QF = (const bf16*)(F.ws + WS_QF); const bf16* KTF = (const bf16*)(F.ws + WS_KTF); const bf16* WF = (const bf16*)(F.ws + WS_WF); const bf16* UC = (const bf16*)(F.ws + WS_UC); const bf16* QKF = (const bf16*)(F.ws + WS_QKF);
    const float* GF = (const float*)(F.ws + WS_GF); const bf16* GZ = (const bf16*)(F.ws + WS_GZ); bf16* CAT = (bf16*)(F.ws + WS_CAT);
    LAS unsigned char* lds = F.lds; LAS float* Ost = (LAS float*)(lds + SC_OST);
    if (wave >= 4) {
        const int lw = wave - 4; v4u st[14]; v4u sg = {0u, 0u, 0u, 0u};
        const int etok = 16 * lw + (lane >> 2), edv = (lane & 3) * 32;
        float go[32];
#pragma unroll
        for (int i = 0; i < 32; ++i) go[i] = A.in[I_GOUTG][edv + i];
#define SC_LOAD(n_) do { const int un_ = bh * 128 + (n_); _Pragma("unroll") for (int i_ = 0; i_ < 14; ++i_) { const int p_ = lw * 64 + lane + 256 * i_; \
            const bf16* s_ = i_ < 4 ? WF + (size_t)un_ * 8192 + (size_t)p_ * 8 : i_ < 8 ? QF + (size_t)un_ * 8192 + (size_t)(p_ - 1024) * 8 : i_ < 12 ? KTF + (size_t)un_ * 8192 + (size_t)(p_ - 2048) * 8 : QKF + (size_t)un_ * 4096 + (size_t)(p_ - 3072) * 8; \
            st[i_] = *(const GAS v4u*)s_; } if (lw == 0 && lane < 48) sg = *(const GAS v4u*)(GF + (size_t)un_ * GF_STRIDE + lane * 4); } while (0)
#define SC_STORE(n_) do { LAS unsigned char* d_ = lds + ((n_) & 1) * SC_BUF; _Pragma("unroll") for (int i_ = 0; i_ < 14; ++i_) *(LAS v4u*)(d_ + (lw * 64 + lane + 256 * i_) * 16) = st[i_]; \
            if (lw == 0 && lane < 48) *(LAS v4u*)(lds + SC_GF + ((n_) & 1) * GF_STRIDE * 4 + lane * 16) = sg; } while (0)
        SC_LOAD(0); SC_STORE(0); LDS_WAIT();
        __syncthreads();
        SC_LOAD(1);
        for (int n = 0; n < 128; ++n) {
            const size_t row = (size_t)b * SEQ + 64 * n + etok;
            v4u zz[4];
#pragma unroll
            for (int i = 0; i < 4; ++i) zz[i] = *(const GAS v4u*)(GZ + row * 512 + h * 128 + edv + 8 * i);
            __syncthreads();
            if (n + 1 < 128) SC_STORE(n + 1);
            LDS_WAIT();
            __syncthreads();
            if (n + 2 < 128) SC_LOAD(n + 2);
            float o[32]; float ss = 0.f;
#pragma unroll
            for (int i = 0; i < 8; ++i) { const f32x4 v = *(const LAS f32x4*)(Ost + etok * OST_LD + edv + 4 * i); o[4 * i] = v[0]; o[4 * i + 1] = v[1]; o[4 * i + 2] = v[2]; o[4 * i + 3] = v[3]; ss += (v[0] * v[0] + v[1] * v[1]) + (v[2] * v[2] + v[3] * v[3]); }
            ss += SWZ_XOR(ss, 1); ss += SWZ_XOR(ss, 2);
            const float rstd = 1.0f / sqrtf(ss * (1.f / 128) + NORM_EPS);
#pragma unroll
            for (int i = 0; i < 4; ++i) { const unsigned zw[4] = {zz[i].x, zz[i].y, zz[i].z, zz[i].w}; v4u ov; unsigned ow[4];
#pragma unroll
                for (int e = 0; e < 4; ++e) { const float z0 = bflo(zw[e]), z1 = bfhi(zw[e]); const int k = 8 * i + 2 * e; ow[e] = pk2(o[k] * rstd * go[k] * silu2(z0), o[k + 1] * rstd * go[k + 1] * silu2(z1)); }
                ov.x = ow[0]; ov.y = ow[1]; ov.z = ow[2]; ov.w = ow[3];
                *(GAS v4u*)(CAT + row * 1024 + 512 + h * 128 + edv + 8 * i) = ov; }
        }
#undef SC_LOAD
#undef SC_STORE
    } else {
        const int dv = 32 * wave + c;
        f32x16 S[4];
#pragma unroll
        for (int t = 0; t < 4; ++t) S[t] = (f32x16){};
        v4u ur[2][2];
#define SC_ULOAD(n_) do { const bf16* up_ = UC + (((size_t)((bh * 128 + (n_)) * 2) * 128 + dv) * 2 + half) * 16; _Pragma("unroll") for (int rb_ = 0; rb_ < 2; ++rb_) { ur[rb_][0] = *(const GAS v4u*)(up_ + (size_t)rb_ * 128 * 32); ur[rb_][1] = *(const GAS v4u*)(up_ + (size_t)rb_ * 128 * 32 + 8); } } while (0)
        SC_ULOAD(0);
        __syncthreads();
        for (int n = 0; n < 128; ++n) {
            const LAS unsigned char* buf = lds + (n & 1) * SC_BUF; const LAS float* gf = (const LAS float*)(lds + SC_GF + (n & 1) * GF_STRIDE * 4);
            bf16x8 Sb[8];
#pragma unroll
            for (int t = 0; t < 4; ++t) { Sb[2 * t] = PACK8(S[t], 0); Sb[2 * t + 1] = PACK8(S[t], 8); }
            f32x16 o[2], P[2];
#pragma unroll
            for (int rb = 0; rb < 2; ++rb) { o[rb] = (f32x16){}; P[rb] = (f32x16){};
#pragma unroll
                for (int ks = 0; ks < 8; ++ks) { P[rb] = MFMA32(*(const LAS bf16x8*)(buf + SC_W + ((rb * 8 + ks) * 64 + lane) * 16), Sb[ks], P[rb]); o[rb] = MFMA32(*(const LAS bf16x8*)(buf + SC_Q + ((rb * 8 + ks) * 64 + lane) * 16), Sb[ks], o[rb]); } }
            bf16x8 VNb[4], VNd[4];
#pragma unroll
            for (int rb = 0; rb < 2; ++rb) { const unsigned uw[8] = {ur[rb][0].x, ur[rb][0].y, ur[rb][0].z, ur[rb][0].w, ur[rb][1].x, ur[rb][1].y, ur[rb][1].z, ur[rb][1].w}; float vn[16], vd[16];
#pragma unroll
                for (int a = 0; a < 4; ++a) { const f32x4 eg = *(const LAS f32x4*)(gf + 32 * rb + 8 * a + 4 * half), dd = *(const LAS f32x4*)(gf + 64 + 32 * rb + 8 * a + 4 * half);
#pragma unroll
                    for (int e = 0; e < 4; ++e) { const int reg = 4 * a + e; const float u = (reg & 1) ? bfhi(uw[reg >> 1]) : bflo(uw[reg >> 1]); vn[reg] = u - P[rb][reg]; vd[reg] = vn[reg] * dd[e]; o[rb][reg] *= eg[e]; } }
                VNb[2 * rb] = PACK8(vn, 0); VNb[2 * rb + 1] = PACK8(vn, 8); VNd[2 * rb] = PACK8(vd, 0); VNd[2 * rb + 1] = PACK8(vd, 8); }
            if (n + 1 < 128) SC_ULOAD(n + 1);
#pragma unroll
            for (int ks = 0; ks < 2; ++ks) o[0] = MFMA32(*(const LAS bf16x8*)(buf + SC_QK + ((0 * 4 + ks) * 64 + lane) * 16), VNb[ks], o[0]);
#pragma unroll
            for (int ks = 0; ks < 4; ++ks) o[1] = MFMA32(*(const LAS bf16x8*)(buf + SC_QK + ((1 * 4 + ks) * 64 + lane) * 16), VNb[ks], o[1]);
            __syncthreads();
#pragma unroll
            for (int rb = 0; rb < 2; ++rb)
#pragma unroll
                for (int reg = 0; reg < 16; ++reg) Ost[(32 * rb + (reg & 3) + 8 * (reg >> 2) + 4 * half) * OST_LD + dv] = o[rb][reg];
            const float gam = gf[128];
            LDS_WAIT();
#pragma unroll
            for (int t = 0; t < 4; ++t) { S[t] *= gam;
#pragma unroll
                for (int ks = 0; ks < 4; ++ks) S[t] = MFMA32(*(const LAS bf16x8*)(buf + SC_KT + ((t * 4 + ks) * 64 + lane) * 16), VNd[ks], S[t]); }
            __syncthreads();
        }
#undef SC_ULOAD
    }
}

typedef _Float16 f16x8 __attribute__((ext_vector_type(8)));
typedef float f32x4v __attribute__((ext_vector_type(4)));
constexpr int SEL_CAP = 512, SEL_TRIG = SEL_CAP - 16, SEL_WAVE_LDS = 16384;
__device__ __forceinline__ float unsortable(unsigned k) { const unsigned u = (k & 0x80000000u) ? (k & 0x7fffffffu) : ~k; return __builtin_bit_cast(float, u); }
__device__ __forceinline__ unsigned sel_compact(LAS unsigned* ck, LAS unsigned short* ci, int n, int lane) {
    unsigned k[8]; unsigned short id[8];
#pragma unroll
    for (int j = 0; j < 8; ++j) { const int e = j * 64 + lane; k[j] = e < n ? ck[e] : 0u; id[j] = e < n ? ci[e] : (unsigned short)0; }
    unsigned cur = 0u;
#pragma unroll 1
    for (int bit = 31; bit >= 0; --bit) { const unsigned v = cur | (1u << bit); int c = 0;
#pragma unroll
        for (int j = 0; j < 8; ++j) c += (int)__popcll(__ballot(k[j] >= v));
        if (c >= TOPK) cur = v; }
    int cgt = 0;
#pragma unroll
    for (int j = 0; j < 8; ++j) cgt += (int)__popcll(__ballot(k[j] > cur));
    const int need = TOPK - cgt; int outc = 0, eqc = 0; const unsigned long long lt = (1ull << lane) - 1ull;
#pragma unroll
    for (int j = 0; j < 8; ++j) { const bool gt = k[j] > cur, eq = k[j] == cur; const unsigned long long eb = __ballot(eq);
        const bool take = gt || (eq && (eqc + (int)__popcll(eb & lt)) < need); const unsigned long long tb = __ballot(take);
        if (take) { const int pos = outc + (int)__popcll(tb & lt); ck[pos] = k[j]; ci[pos] = id[j]; }
        outc += (int)__popcll(tb); eqc += (int)__popcll(eb); }
    LDS_WAIT(); asm volatile("" ::: "memory");
    return cur;
}
__device__ __forceinline__ unsigned wave_max_u32(unsigned v) {
#define SWZU_(m_) { const unsigned o = (unsigned)__builtin_amdgcn_ds_swizzle((int)v, (((m_) << 10) | 0x1f)); v = v > o ? v : o; }
    SWZU_(1) SWZU_(2) SWZU_(4) SWZU_(8) SWZU_(16)
#undef SWZU_
    auto rr = __builtin_amdgcn_permlane32_swap(v, v, false, false); return rr[0] > rr[1] ? rr[0] : rr[1];
}
__device__ __forceinline__ unsigned wave_min_u32(unsigned v) {
#define SWZU_(m_) { const unsigned o = (unsigned)__builtin_amdgcn_ds_swizzle((int)v, (((m_) << 10) | 0x1f)); v = v < o ? v : o; }
    SWZU_(1) SWZU_(2) SWZU_(4) SWZU_(8) SWZU_(16)
#undef SWZU_
    auto rr = __builtin_amdgcn_permlane32_swap(v, v, false, false); return rr[0] < rr[1] ? rr[0] : rr[1];
}
__device__ __forceinline__ int sel_compact_fast(LAS unsigned* ck, LAS unsigned short* ci, int n, int lane, unsigned* thr) {
    unsigned k[8]; unsigned short id[8]; unsigned mx = 0u, mn = 0xffffffffu;
#pragma unroll
    for (int j = 0; j < 8; ++j) { const int e = j * 64 + lane; const bool in = e < n; k[j] = in ? ck[e] : 0u; id[j] = in ? ci[e] : (unsigned short)0; mx = (in && k[j] > mx) ? k[j] : mx; mn = (in && k[j] < mn) ? k[j] : mn; }
    unsigned lo = (unsigned)__builtin_amdgcn_readfirstlane((int)wave_min_u32(mn)), hi = (unsigned)__builtin_amdgcn_readfirstlane((int)wave_max_u32(mx)); int clo = n;
#pragma unroll 1
    for (int it = 0; it < 9 && hi - lo > 1u; ++it) { const unsigned v = lo + ((hi - lo) >> 1); int c = 0;
#pragma unroll
        for (int j = 0; j < 8; ++j) c += (int)__popcll(__ballot(k[j] >= v));
        if (c >= TOPK) { lo = v; clo = c; } else hi = v; }
    if (clo > 416) { *thr = sel_compact(ck, ci, n, lane); return TOPK; }
    int outc = 0; const unsigned long long lt = (1ull << lane) - 1ull;
#pragma unroll
    for (int j = 0; j < 8; ++j) { const bool take = k[j] >= lo && (j * 64 + lane) < n; const unsigned long long tb = __ballot(take);
        if (take) { const int pos = outc + (int)__popcll(tb & lt); ck[pos] = k[j]; ci[pos] = id[j]; }
        outc += (int)__popcll(tb); }
    LDS_WAIT(); asm volatile("" ::: "memory");
    *thr = lo - 1u; return outc;
}
__device__ __forceinline__ void p_dsa_select(Frame& F, int gw0, int ngw) {
    int lane = F.lane; asm volatile("" : "+v"(lane));
    const __half* QIDX = (const __half*)(F.ws + WS_QIDX); const __half* KIDX = (const __half*)(F.ws + WS_KIDX); const float* WIDX = (const float*)(F.ws + WS_WIDX);
    unsigned long long* MASKT = (unsigned long long*)(F.ws + WS_MASK);
    LAS unsigned char* wl = F.lds + F.wave * SEL_WAVE_LDS;
    { unsigned wb_ = (unsigned)(uintptr_t)wl; asm volatile("" : "+v"(wb_)); wl = (LAS unsigned char*)(uintptr_t)wb_; }
    LAS unsigned* CK = (LAS unsigned*)wl;
    LAS unsigned short* CI = (LAS unsigned short*)(wl + 8192);
    LAS unsigned* MR = (LAS unsigned*)(wl + 12288);
    const int col = lane & 15, grp = lane >> 4;
#pragma unroll 1
    for (int rnd = 0; rnd * ngw < 4096; ++rnd) {
        const int rk = rnd * ngw + ((rnd & 1) ? ngw - 1 - gw0 : gw0); if (rk >= 4096) continue;
        const int b = rk & 1, u = 2047 - (rk >> 1); const int t0 = 4 * u; const size_t m0 = (size_t)b * SEQ + t0;
        f16x8 qa[2];
#pragma unroll
        for (int ks = 0; ks < 2; ++ks) qa[ks] = *(const GAS f16x8*)(QIDX + (m0 + (col >> 2)) * 256 + (col & 3) * 64 + 32 * ks + 8 * grp);
        const f32x4v wq = *(const GAS f32x4v*)(WIDX + (m0 + grp) * 4);
        const int tq = t0 + grp;
        unsigned tau0 = 0u, tau1 = 0u, tau2 = 0u, tau3 = 0u; int c0 = 0, c1 = 0, c2 = 0, c3 = 0;
        const int ntiles = (t0 + 3) / 16 + 1;
        const __half* kbase = KIDX + ((size_t)b * SEQ + col) * 64 + 8 * grp;
        f16x8 cb[4][2], nb[4][2];
#pragma unroll
        for (int i = 0; i < 4; ++i) { const int tl = i < ntiles ? i : ntiles - 1;
#pragma unroll
            for (int ks = 0; ks < 2; ++ks) cb[i][ks] = *(const GAS f16x8*)(kbase + (size_t)tl * 16 * 64 + 32 * ks); }
#pragma unroll 1
        for (int tile = 0; tile < ntiles; tile += 4) {
#pragma unroll
            for (int i = 0; i < 4; ++i) { int tl = tile + 4 + i; tl = tl < ntiles ? tl : ntiles - 1;
#pragma unroll
                for (int ks = 0; ks < 2; ++ks) nb[i][ks] = *(const GAS f16x8*)(kbase + (size_t)tl * 16 * 64 + 32 * ks); }
#pragma unroll
            for (int i = 0; i < 4; ++i) {
                if (tile + i < ntiles) {
                    f32x4v acc = {0.f, 0.f, 0.f, 0.f};
                    acc = __builtin_amdgcn_mfma_f32_16x16x32_f16(qa[0], cb[i][0], acc, 0, 0, 0);
                    acc = __builtin_amdgcn_mfma_f32_16x16x32_f16(qa[1], cb[i][1], acc, 0, 0, 0);
                    const float sc = wq[0] * fmaxf(acc[0], 0.f) + wq[1] * fmaxf(acc[1], 0.f) + wq[2] * fmaxf(acc[2], 0.f) + wq[3] * fmaxf(acc[3], 0.f);
                    const int key = 16 * (tile + i) + col;
                    const unsigned tau = grp == 0 ? tau0 : grp == 1 ? tau1 : grp == 2 ? tau2 : tau3; const unsigned sk = sortable(sc);
                    const bool pass = key <= tq && sk > tau;
                    const unsigned long long bal = __ballot(pass);
                    if (bal) {
                        const unsigned gb = (unsigned)(bal >> (16 * grp)) & 0xffffu; const int cg = grp == 0 ? c0 : grp == 1 ? c1 : grp == 2 ? c2 : c3;
                        if (pass) { const int slot = cg + (int)__popc(gb & ((1u << col) - 1u)); CK[grp * SEL_CAP + slot] = sk; CI[grp * SEL_CAP + slot] = (unsigned short)key; }
                        c0 += (int)__popc((unsigned)bal & 0xffffu); c1 += (int)__popc((unsigned)(bal >> 16) & 0xffffu); c2 += (int)__popc((unsigned)(bal >> 32) & 0xffffu); c3 += (int)__popc((unsigned)(bal >> 48) & 0xffffu);
                        if (c0 > SEL_TRIG || c1 > SEL_TRIG || c2 > SEL_TRIG || c3 > SEL_TRIG) {
                            LDS_WAIT(); asm volatile("" ::: "memory");
                            if (c0 > SEL_TRIG) c0 = sel_compact_fast(CK, CI, c0, lane, &tau0);
                            if (c1 > SEL_TRIG) c1 = sel_compact_fast(CK + SEL_CAP, CI + SEL_CAP, c1, lane, &tau1);
                            if (c2 > SEL_TRIG) c2 = sel_compact_fast(CK + 2 * SEL_CAP, CI + 2 * SEL_CAP, c2, lane, &tau2);
                            if (c3 > SEL_TRIG) c3 = sel_compact_fast(CK + 3 * SEL_CAP, CI + 3 * SEL_CAP, c3, lane, &tau3);
                        }
                    }
                }
            }
#pragma unroll
            for (int i = 0; i < 4; ++i)
#pragma unroll
                for (int ks = 0; ks < 2; ++ks) cb[i][ks] = nb[i][ks];
        }
        LDS_WAIT(); asm volatile("" ::: "memory");
        if (c0 > TOPK) { (void)sel_compact(CK, CI, c0, lane); c0 = TOPK; }
        if (c1 > TOPK) { (void)sel_compact(CK + SEL_CAP, CI + SEL_CAP, c1, lane); c1 = TOPK; }
        if (c2 > TOPK) { (void)sel_compact(CK + 2 * SEL_CAP, CI + 2 * SEL_CAP, c2, lane); c2 = TOPK; }
        if (c3 > TOPK) { (void)sel_compact(CK + 3 * SEL_CAP, CI + 3 * SEL_CAP, c3, lane); c3 = TOPK; }
#pragma unroll
        for (int j = 0; j < 16; ++j) MR[j * 64 + lane] = 0u;
        LDS_WAIT(); asm volatile("" ::: "memory");
#pragma unroll
        for (int q = 0; q < 4; ++q) { const int cq = q == 0 ? c0 : q == 1 ? c1 : q == 2 ? c2 : c3;
#pragma unroll
            for (int j = 0; j < 4; ++j) { const int e = j * 64 + lane; if (e < cq) { const unsigned kidx = CI[q * SEL_CAP + e]; __hip_atomic_fetch_or(MR + q * 256 + (kidx >> 5), 1u << (kidx & 31), __ATOMIC_RELAXED, __HIP_MEMORY_SCOPE_WORKGROUP); } } }
        LDS_WAIT(); asm volatile("" ::: "memory");
#pragma unroll
        for (int j = 0; j < 2; ++j) { const int w = lane + 64 * j; v4u a, c;
            a.x = MR[0 * 256 + 2 * w]; a.y = MR[0 * 256 + 2 * w + 1]; a.z = MR[1 * 256 + 2 * w]; a.w = MR[1 * 256 + 2 * w + 1];
            c.x = MR[2 * 256 + 2 * w]; c.y = MR[2 * 256 + 2 * w + 1]; c.z = MR[3 * 256 + 2 * w]; c.w = MR[3 * 256 + 2 * w + 1];
            GAS v4u* dst = (GAS v4u*)(MASKT + ((size_t)(b * 128 + w) * SEQ + t0));
            dst[0] = a; dst[1] = c; }
        LDS_WAIT(); asm volatile("" ::: "memory");
    }
}

#define XB_TMO      128
#define XB_XCNT(j)  (256  + 64 * (j))
#define XB_XSUB(j)  (1280 + 64 * (j))
#define XB_XGEN(j)  (2304 + 64 * (j))
#define XB_TOP      3328
#define XB_TOPGEN   3392
#define XCD_BAR_WORDS 3456
#define XB_SPIN_CAP (1u << 18)

__device__ __forceinline__ unsigned xb_ld(unsigned* p)              { return __hip_atomic_load(p, __ATOMIC_RELAXED, __HIP_MEMORY_SCOPE_AGENT); }
__device__ __forceinline__ unsigned xb_add(unsigned* p, unsigned v) { return __hip_atomic_fetch_add(p, v, __ATOMIC_RELAXED, __HIP_MEMORY_SCOPE_AGENT); }
__device__ __forceinline__ unsigned xb_xcc_id() { return (unsigned)__builtin_amdgcn_s_getreg((3 << 11) | 20) & 0xFu; }
#define XB_SPIN(cond, bar) do { unsigned _sp = 0; while (cond) { __builtin_amdgcn_s_sleep(1); \
    if ((++_sp & 255u) == 0u) { if (xb_ld(&(bar)[XB_TMO])) break; if (_sp > XB_SPIN_CAP) { atomicAdd(&(bar)[XB_TMO], 1u); break; } } } } while (0)

struct XcdBarrier {
    unsigned* bar; unsigned x; unsigned total;
    volatile LAS unsigned* st;
};

__device__ __forceinline__ XcdBarrier xcd_barrier_post(unsigned* bar, volatile LAS unsigned* st, unsigned total) {
    XcdBarrier b; b.bar = bar; b.x = xb_xcc_id(); b.st = st; b.total = total;
    if (threadIdx.x == 0) (void)xb_add(&bar[XB_XCNT(b.x)], 1u);
    return b;
}
__device__ __forceinline__ void xcd_barrier_complete(unsigned* bar, unsigned x, unsigned& nloc, unsigned& nx, unsigned G) {
    unsigned sum, cnt, mine, sp = 0u;
    for (;;) {
        sum = 0u; cnt = 0u; mine = 0u;
#pragma unroll
        for (unsigned j = 0; j < 16; ++j) { const unsigned c = xb_ld(&bar[XB_XCNT(j)]); sum += c; cnt += (c > 0u) ? 1u : 0u; mine = (j == x) ? c : mine; }
        if (sum == G) break;
        __builtin_amdgcn_s_sleep(1);
        if ((++sp & 255u) == 0u) { if (xb_ld(&bar[XB_TMO])) break; if (sp > XB_SPIN_CAP) { atomicAdd(&bar[XB_TMO], 1u); break; } }
    }
    nloc = mine > 0u ? mine : 1u; nx = cnt > 0u ? cnt : 1u;
}

__device__ __forceinline__ void xcd_barrier(const XcdBarrier& b) {
    asm volatile("s_waitcnt vmcnt(0)" ::: "memory");
    __syncthreads();
    if (threadIdx.x == 0) {
        unsigned* bar = b.bar;
        __builtin_amdgcn_s_waitcnt(0);
        unsigned nloc = b.st[0], nx = b.st[1];
        if (nloc == 0u) { xcd_barrier_complete(bar, b.x, nloc, nx, b.total); b.st[0] = nloc; b.st[1] = nx; }
        const unsigned old = xb_add(&bar[XB_XSUB(b.x)], 1u);
        const unsigned gen = old / nloc;
        if (old + 1u == (gen + 1u) * nloc) {
            __builtin_amdgcn_fence(__ATOMIC_RELEASE, "agent");
            asm volatile("s_waitcnt vmcnt(0)" ::: "memory");
            const unsigned og = xb_add(&bar[XB_TOP], 1u);
            const unsigned tg = og / nx;
            if (og + 1u == (tg + 1u) * nx) xb_add(&bar[XB_TOPGEN], 1u);
            else XB_SPIN(xb_ld(&bar[XB_TOPGEN]) == tg, bar);
            __builtin_amdgcn_fence(__ATOMIC_ACQUIRE, "agent");
            xb_add(&bar[XB_XGEN(b.x)], 1u);
            asm volatile("s_waitcnt vmcnt(0)" ::: "memory");
        } else {
            XB_SPIN(xb_ld(&bar[XB_XGEN(b.x)]) == gen, bar);
            __builtin_amdgcn_fence(__ATOMIC_ACQUIRE, "agent");
            asm volatile("s_waitcnt vmcnt(0)" ::: "memory");
        }
    }
    __syncthreads();
}
#ifndef XMASK
#define XMASK 0
#endif
#ifndef RMASK
#define RMASK 0
#endif
#ifndef RSCAN
#define RSCAN 1
#endif
#ifndef RSEL
#define RSEL 1
#endif
enum { PH_PRO = 0, PH_F1A, PH_F1B, PH_ROW1, PH_INPROJ, PH_PREP1, PH_REGION, PH_OUTPROJ, PH_ROW2, PH_F2A, PH_F2B, PH_ROW3, PH_N };

__global__ void __launch_bounds__(NTHR, 2) mega_fwd(Args args) {
    extern __shared__ __attribute__((aligned(16))) unsigned char lds[];
    Frame F; F.lds = (LAS unsigned char*)lds; F.tid = threadIdx.x; F.lane = F.tid & 63; F.wave = __builtin_amdgcn_readfirstlane(F.tid >> 6); F.G = gridDim.x; F.bid = blockIdx.x; F.ws = args.ws;
    unsigned char* ws = args.ws;
    const int lo = args.ph_lo, hi = args.ph_hi;
#define IN(k) (lo <= (k) && (k) < hi)
#define SEAM(k) do { if (IN(k) && IN((k) + 1)) BAR_MAIN(); FRESH(); } while (0)
#define FRESH() do { int t_ = threadIdx.x; asm volatile("" : "+v"(t_)); F.tid = t_; F.lane = t_ & 63; \
        F.wave = __builtin_amdgcn_readfirstlane(t_ >> 6); XN = (bf16*)(ws + WS_XN); FB = (bf16*)(ws + WS_FB); HID = (bf16*)(ws + WS_HID); } while (0)
    bf16* XN = (bf16*)(ws + WS_XN); bf16* FB = (bf16*)(ws + WS_FB); bf16* HID = (bf16*)(ws + WS_HID);
    { volatile LAS unsigned* misc = (volatile LAS unsigned*)(F.lds + LDS_MISC_OFF); if (F.tid < 16) misc[F.tid] = 0u; }
    __syncthreads();
    (void)xcd_barrier_post((unsigned*)(ws + WS_CTL) + CW_BAR, (volatile LAS unsigned*)(F.lds + LDS_MISC_OFF), (unsigned)F.G);
    if (F.bid >= 8) (void)xcd_barrier_post((unsigned*)(ws + WS_CTL) + CW_BAR2, (volatile LAS unsigned*)(F.lds + LDS_MISC_OFF + 8), (unsigned)(F.G - 8));
#define BAR_MAIN() do { XcdBarrier b_; b_.bar = (unsigned*)(args.ws + WS_CTL) + CW_BAR; b_.x = xb_xcc_id(); b_.total = gridDim.x; b_.st = (volatile LAS unsigned*)((LAS unsigned char*)lds + LDS_MISC_OFF); xcd_barrier(b_); } while (0)
#define BAR_SUB() do { XcdBarrier b_; b_.bar = (unsigned*)(args.ws + WS_CTL) + CW_BAR2; b_.x = xb_xcc_id(); b_.total = gridDim.x - 8; b_.st = (volatile LAS unsigned*)((LAS unsigned char*)lds + LDS_MISC_OFF + 8); xcd_barrier(b_); } while (0)
    FRESH();
    if (IN(PH_PRO) && !(XMASK >> PH_PRO & 1)) { p_prologue(F, args); } if ((RMASK >> PH_PRO) & 1) { BAR_MAIN(); { p_prologue(F, args); } } SEAM(PH_PRO);
    if (IN(PH_F1A) && !(XMASK >> PH_F1A & 1)) { pg8::Gemm g{XN, (const bf16*)(ws + WS_WA), TT, 2 * DFF, DM}; pg8::StaticOrder S; S.init(TT, 2 * DFF, F.G, F.bid); pg8::EpiSwiGLU E{HID, DFF};
        pg8::gemm_phase<pg8::EpiSwiGLU, pg8::StaticOrder, true, true>(F.lds, g, S, E); } if ((RMASK >> PH_F1A) & 1) { BAR_MAIN(); { pg8::Gemm g{XN, (const bf16*)(ws + WS_WA), TT, 2 * DFF, DM}; pg8::StaticOrder S; S.init(TT, 2 * DFF, F.G, F.bid); pg8::EpiSwiGLU E{HID, DFF};
        pg8::gemm_phase<pg8::EpiSwiGLU, pg8::StaticOrder, true, true>(F.lds, g, S, E); } } SEAM(PH_F1A);
    if (IN(PH_F1B) && !(XMASK >> PH_F1B & 1)) { pg8::Gemm g{HID, (const bf16*)(ws + WS_WB), TT, DM, DFF}; pg8::StaticOrder S; S.init(TT, DM, F.G, F.bid); pg8::EpiPlain E{FB, DM};
        pg8::gemm_phase<pg8::EpiPlain, pg8::StaticOrder, true, true>(F.lds, g, S, E); } if ((RMASK >> PH_F1B) & 1) { BAR_MAIN(); { pg8::Gemm g{HID, (const bf16*)(ws + WS_WB), TT, DM, DFF}; pg8::StaticOrder S; S.init(TT, DM, F.G, F.bid); pg8::EpiPlain E{FB, DM};
        pg8::gemm_phase<pg8::EpiPlain, pg8::StaticOrder, true, true>(F.lds, g, S, E); } } SEAM(PH_F1B);
    if (IN(PH_ROW1) && !(XMASK >> PH_ROW1 & 1)) { p_rowpass(F, FB, args.in[I_X], args.in[I_F1POST], 0.5f, args.out, args.in[I_MPRE], XN); } if ((RMASK >> PH_ROW1) & 1) { BAR_MAIN(); { p_rowpass(F, FB, args.in[I_X], args.in[I_F1POST], 0.5f, args.out, args.in[I_MPRE], XN); } } SEAM(PH_ROW1);
    if (IN(PH_INPROJ) && !(XMASK >> PH_INPROJ & 1)) { pg8::Gemm g{XN, (const bf16*)(ws + WS_WIN), TT, DINP, DM}; pg8::StaticOrder S; S.init(TT, DINP, F.G, F.bid);
        pg8::EpiInProj E{(bf16*)(ws + WS_CQ), (bf16*)(ws + WS_KATT), (bf16*)(ws + WS_VATT), (bf16*)(ws + WS_GRAW), (bf16*)(ws + WS_GZ), (float*)(ws + WS_SPEC)};
        pg8::gemm_phase<pg8::EpiInProj, pg8::StaticOrder, true, true>(F.lds, g, S, E); } if ((RMASK >> PH_INPROJ) & 1) { BAR_MAIN(); { pg8::Gemm g{XN, (const bf16*)(ws + WS_WIN), TT, DINP, DM}; pg8::StaticOrder S; S.init(TT, DINP, F.G, F.bid);
        pg8::EpiInProj E{(bf16*)(ws + WS_CQ), (bf16*)(ws + WS_KATT), (bf16*)(ws + WS_VATT), (bf16*)(ws + WS_GRAW), (bf16*)(ws + WS_GZ), (float*)(ws + WS_SPEC)};
        pg8::gemm_phase<pg8::EpiInProj, pg8::StaticOrder, true, true>(F.lds, g, S, E); } } SEAM(PH_INPROJ);
    if (IN(PH_PREP1) && !(XMASK >> PH_PREP1 & 1)) { p_prep1(F, args);
        asm volatile("s_waitcnt vmcnt(0)" ::: "memory"); __syncthreads();
        if (!(F.wave & 1)) gdn_pre_unit(F, ((F.bid >> 7) * 4 + (F.wave >> 1)) * 128 + (F.bid & 127), F.lds + (F.wave >> 1) * 33792);
    } SEAM(PH_PREP1);
    if (IN(PH_REGION) && !(XMASK >> PH_REGION & 1)) {
        if (blockIdx.x < 8) { FRESH();
#if defined(GDN_NAIVE)
            p_gdn_naive(F, args, F.bid);
#else
#ifndef NO_SCAN
            p_gdn_scan(F, args, F.bid);
#endif
#endif
        } else {
            const int sb = (int)blockIdx.x - 8, sG = (int)gridDim.x - 8; FRESH();
            { pg8::Gemm g{(const bf16*)(ws + WS_CQ), (const bf16*)(ws + WS_WQ), TT, 768, 256}; pg8::StaticOrder S; S.init(TT, 768, sG, sb); pg8::EpiQ E{(bf16*)(ws + WS_QRAWQ), (bf16*)(ws + WS_QRAWI)};
              pg8::gemm_phase<pg8::EpiQ, pg8::StaticOrder, true, true>(F.lds, g, S, E); }
            BAR_SUB(); FRESH();
            p_prep2(F, args, sb * NWAVES + F.wave, sG * NWAVES);
            BAR_SUB(); FRESH();
#ifndef NO_SEL
            p_dsa_select(F, sb * NWAVES + F.wave, sG * NWAVES);
#endif
            BAR_SUB(); FRESH();
            { const attn_body::AttnTensors AT{(const attn_body::bf16*)(ws + WS_Q), (const attn_body::bf16*)(ws + WS_KATT), (const attn_body::bf16*)(ws + WS_VATT), (attn_body::bf16*)(ws + WS_CAT), (const unsigned long long*)(ws + WS_MASK)};
              const attn_body::QueueOrder S{(unsigned*)(ws + WS_CTL) + CW_QUEUE, (LAS int*)(F.lds + LDS_MISC_OFF + 16)};
#ifndef NO_ATT
              attn_body::attn_phase<attn_body::QueueOrder>((char*)lds, AT, S);
#endif
            }
        }
    } SEAM(PH_REGION);
    if (IN(PH_OUTPROJ) && !(XMASK >> PH_OUTPROJ & 1)) { pg8::Gemm g{(const bf16*)(ws + WS_CAT), (const bf16*)(ws + WS_WOUT), TT, DM, DM}; pg8::StaticOrder S; S.init(TT, DM, F.G, F.bid); pg8::EpiPlain E{FB, DM};
        pg8::gemm_phase<pg8::EpiPlain, pg8::StaticOrder, true, true>(F.lds, g, S, E); } if ((RMASK >> PH_OUTPROJ) & 1) { BAR_MAIN(); { pg8::Gemm g{(const bf16*)(ws + WS_CAT), (const bf16*)(ws + WS_WOUT), TT, DM, DM}; pg8::StaticOrder S; S.init(TT, DM, F.G, F.bid); pg8::EpiPlain E{FB, DM};
        pg8::gemm_phase<pg8::EpiPlain, pg8::StaticOrder, true, true>(F.lds, g, S, E); } } SEAM(PH_OUTPROJ);
    if (IN(PH_ROW2) && !(XMASK >> PH_ROW2 & 1)) { conv_ffn_weights(F, args, 1); p_rowpass(F, FB, args.out, args.in[I_MPOST], 1.0f, args.out, args.in[I_F2PRE], XN); } SEAM(PH_ROW2);
    if (IN(PH_F2A) && !(XMASK >> PH_F2A & 1)) { pg8::Gemm g{XN, (const bf16*)(ws + WS_WA), TT, 2 * DFF, DM}; pg8::StaticOrder S; S.init(TT, 2 * DFF, F.G, F.bid); pg8::EpiSwiGLU E{HID, DFF};
        pg8::gemm_phase<pg8::EpiSwiGLU, pg8::StaticOrder, true, true>(F.lds, g, S, E); } SEAM(PH_F2A);
    if (IN(PH_F2B) && !(XMASK >> PH_F2B & 1)) { pg8::Gemm g{HID, (const bf16*)(ws + WS_WB), TT, DM, DFF}; pg8::StaticOrder S; S.init(TT, DM, F.G, F.bid); pg8::EpiPlain E{FB, DM};
        pg8::gemm_phase<pg8::EpiPlain, pg8::StaticOrder, true, true>(F.lds, g, S, E); } SEAM(PH_F2B);
    if (IN(PH_ROW3) && !(XMASK >> PH_ROW3 & 1)) { p_rowpass(F, FB, args.out, args.in[I_F2POST], 0.5f, args.out, nullptr, nullptr); }
#undef IN
#undef SEAM
}

extern "C" void kernel_launch(void* const* d_in, const int* in_sizes, int n_in, void* d_out, int out_size, void* d_ws, size_t ws_size, hipStream_t stream) {
    static int grid = 0;
    if (grid == 0) {
        if (n_in != 24 || out_size != TT * DM || ws_size < WS_END) { fprintf(stderr, "kernel_launch: unexpected shapes (n_in %d out %d ws %zu)\n", n_in, out_size, ws_size); grid = -1; return; }
        int dev = 0, cus = 0, per_cu = 0;
        hipGetDevice(&dev); hipDeviceGetAttribute(&cus, hipDeviceAttributeMultiprocessorCount, dev);
        if (hipFuncSetAttribute((const void*)mega_fwd, hipFuncAttributeMaxDynamicSharedMemorySize, LDS_BYTES) != hipSuccess) { fprintf(stderr, "kernel_launch: hipFuncSetAttribute failed\n"); grid = -1; return; }
        if (hipOccupancyMaxActiveBlocksPerMultiprocessor(&per_cu, (const void*)mega_fwd, NTHR, LDS_BYTES) != hipSuccess || per_cu < 1) { fprintf(stderr, "kernel_launch: occupancy query says %d\n", per_cu); per_cu = 1; }
        (void)hipGetLastError();
        grid = cus * (per_cu < 1 ? 1 : 1);
        fprintf(stderr, "kernel_launch: cus %d per_cu %d grid %d\n", cus, per_cu, grid);
    }
    if (grid < 0) return;
    Args a{};
    for (int i = 0; i < 24; ++i) a.in[i] = (const float*)d_in[i];
    a.out = (float*)d_out; a.ws = (unsigned char*)d_ws;
    for (int i = 0; i < 32; ++i) a.invf_att[i] = 1.0f / powf(10000.0f, (float)i / 32.0f);
    for (int i = 0; i < 16; ++i) a.invf_idx[i] = 1.0f / powf(10000.0f, (float)i / 16.0f);
    a.ph_lo = 0; a.ph_hi = PH_N;
    if (hipMemsetAsync((char*)d_ws + WS_CTL, 0, CTL_ZERO_BYTES, stream) != hipSuccess) { fprintf(stderr, "kernel_launch: memset failed\n"); return; }
    void* kargs[] = {&a};
    hipError_t e = hipLaunchCooperativeKernel((const void*)mega_fwd, dim3(grid), dim3(NTHR), kargs, LDS_BYTES, stream);
    if (e != hipSuccess) fprintf(stderr, "kernel_launch: cooperative launch failed: %s (grid %d)\n", hipGetErrorString(e), grid);
}
```
